# Optimizing an MI355X kernel written in HIP

```python
import jax
import jax.numpy as jnp
from jax import lax
import numpy as np

D_MODEL = 2048
BATCH = 16
SEQ = 2048
DEPTH = 1

HGRN_HEAD_DIM = 128
HGRN_HEADS = D_MODEL // HGRN_HEAD_DIM
HGRN_WIDTH = HGRN_HEADS * HGRN_HEAD_DIM
HGRN_CHUNK = 32
ATTN_GROUPS = ((128, 1), (512, 4), (2048, 16))
ATTN_HEADS_PER_GROUP = 4
HEAD_DIM = 128
ATTN_QKV_WIDTH = len(ATTN_GROUPS) * 3 * ATTN_HEADS_PER_GROUP * HEAD_DIM
ATTN_OUT_WIDTH = ATTN_HEADS_PER_GROUP * HEAD_DIM
ROPE_THETA = 500000.0
ROPE_DIM = HEAD_DIM // 4
N_BRANCHES = 2
IN_COLS = 5 * HGRN_WIDTH + ATTN_QKV_WIDTH + N_BRANCHES * D_MODEL
D_FF = ((8 * D_MODEL // 3 + 255) // 256) * 256
DEEPNORM_ALPHA = (2.0 * DEPTH) ** 0.25
DEEPNORM_BETA = (8.0 * DEPTH) ** -0.25
LN_EPS = 1e-5
NEG_INF = -1e30

kernel_name = 'hybrid_hgrn2_dilated_attn_macaron_deepnorm'


def layer_norm(x, g, b):
    xf = x.astype(jnp.float32)
    mu = jnp.mean(xf, axis=-1, keepdims=True)
    var = jnp.mean(jnp.square(xf - mu), axis=-1, keepdims=True)
    return ((xf - mu) * lax.rsqrt(var + LN_EPS) * g + b).astype(x.dtype)


def swiglu(x, w_in, w_out):
    gate, up = jnp.split(x @ w_in, 2, axis=-1)
    return (jax.nn.silu(gate) * up) @ w_out


def partial_rope(t, pos):
    t = t.astype(jnp.float32)
    inv_freq = ROPE_THETA ** (-jnp.arange(0, ROPE_DIM, 2, dtype=jnp.float32) / ROPE_DIM)
    ang = pos.astype(jnp.float32)[:, None] * inv_freq
    cos = jnp.cos(ang)[None, :, None, None, :]
    sin = jnp.sin(ang)[None, :, None, None, :]
    t1, t2, rest = jnp.split(t, [ROPE_DIM // 2, ROPE_DIM], axis=-1)
    return jnp.concatenate([t1 * cos - t2 * sin, t2 * cos + t1 * sin, rest], axis=-1)


def dilated_window_attention(q, k, v, window, dilation):
    b_, s_, h_, dh = q.shape
    half = window // (2 * dilation)
    seg = s_ // dilation
    blk = half
    n_blk = -(-seg // blk)
    seg_p = n_blk * blk

    def to_residue(t):
        t = t.reshape(b_, seg, dilation, h_, dh).transpose(0, 2, 3, 1, 4)
        return jnp.pad(t, ((0, 0), (0, 0), (0, 0), (0, seg_p - seg), (0, 0)))

    def neighbours(t):
        t = jnp.pad(t, ((0, 0), (0, 0), (0, 0), (blk, blk), (0, 0)))
        t = t.reshape(b_, dilation, h_, n_blk + 2, blk, dh)
        return jnp.concatenate([t[:, :, :, :-2], t[:, :, :, 1:-1], t[:, :, :, 2:]], axis=4)

    qr = to_residue(q).reshape(b_, dilation, h_, n_blk, blk, dh)
    kr = neighbours(to_residue(k))
    vr = neighbours(to_residue(v))
    qi = jnp.arange(seg_p).reshape(n_blk, blk, 1)
    kj = (jnp.arange(n_blk)[:, None, None] - 1) * blk + jnp.arange(3 * blk)[None, None, :]
    valid = (jnp.abs(qi - kj) <= half) & (kj >= 0) & (kj < seg)
    s = jnp.einsum('brhnqe,brhnke->brhnqk', qr, kr).astype(jnp.float32) * (HEAD_DIM ** -0.5)
    s = jnp.where(valid, s, NEG_INF)
    m = jnp.max(s, axis=-1, keepdims=True)
    p = jnp.exp(s - m)
    denom = jnp.sum(p, axis=-1, keepdims=True)
    o = jnp.einsum('brhnqk,brhnke->brhnqe', p, vr.astype(jnp.float32)) / denom
    lse = (m + jnp.log(denom))[..., 0]
    o = o.reshape(b_, dilation, h_, seg_p, dh)[:, :, :, :seg]
    o = o.transpose(0, 3, 1, 2, 4).reshape(b_, s_, h_, dh)
    lse = lse.reshape(b_, dilation, h_, seg_p)[:, :, :, :seg]
    lse = lse.transpose(0, 3, 1, 2).reshape(b_, s_, h_)
    return o, lse


def dilated_attention_mixer(h_qkv):
    b_, s_, _ = h_qkv.shape
    qkv = h_qkv.reshape(b_, s_, len(ATTN_GROUPS), 3, ATTN_HEADS_PER_GROUP, HEAD_DIM)
    pos = jnp.arange(s_)
    q = partial_rope(qkv[:, :, :, 0], pos)
    k = partial_rope(qkv[:, :, :, 1], pos)
    v = qkv[:, :, :, 2]
    outs, lses = [], []
    for g, (window, dilation) in enumerate(ATTN_GROUPS):
        o_g, lse_g = dilated_window_attention(q[:, :, g], k[:, :, g], v[:, :, g], window, dilation)
        outs.append(o_g)
        lses.append(lse_g)
    w = jax.nn.softmax(jnp.stack(lses, axis=0), axis=0)
    o = jnp.sum(w[..., None] * jnp.stack(outs, axis=0), axis=0)
    return o.reshape(b_, s_, ATTN_OUT_WIDTH)


def hgrn2_chunk_scan(q, f, v):
    b_, s_, h_, dk = q.shape
    dv = v.shape[-1]
    n_chunks = s_ // HGRN_CHUNK

    def chunks(t):
        return t.reshape(b_, n_chunks, HGRN_CHUNK, h_, t.shape[-1]).transpose(0, 3, 1, 2, 4)

    qc, fc, vc = chunks(q), chunks(f), chunks(v)
    kc = 1.0 - fc
    cum = jnp.cumsum(jnp.log(fc), axis=3)
    cum_last = cum[:, :, :, -1:]
    q_dec = qc * jnp.exp(cum)
    k_dec = kc * jnp.exp(-cum)
    k_end = kc * jnp.exp(cum_last - cum)
    tril = jnp.tril(jnp.ones((HGRN_CHUNK, HGRN_CHUNK), dtype=bool))
    a = jnp.where(tril, jnp.einsum('bhncd,bhnsd->bhncs', q_dec, k_dec), 0.0)
    o_intra = jnp.einsum('bhncs,bhnsv->bhncv', a, vc)
    decay = jnp.exp(cum_last[:, :, :, 0])

    def step(state, inp):
        q_n, k_n, v_n, dec_n = inp
        o_n = jnp.einsum('bhcd,bhdv->bhcv', q_n, state)
        state = dec_n[..., None] * state + jnp.einsum('bhcd,bhcv->bhdv', k_n, v_n)
        return state, o_n

    xs = (jnp.moveaxis(q_dec, 2, 0), jnp.moveaxis(k_end, 2, 0),
          jnp.moveaxis(vc, 2, 0), jnp.moveaxis(decay, 2, 0))
    _, o_inter = lax.scan(step, jnp.zeros((b_, h_, dk, dv), jnp.float32), xs)
    o = o_intra + jnp.moveaxis(o_inter, 0, 2)
    return o.transpose(0, 2, 3, 1, 4).reshape(b_, s_, h_, dv)


def bidirectional_hgrn2(hq, hf_fwd, hf_bwd, hi, hog, lb_fwd, lb_bwd, layer, norm_g):
    b_, s_, _ = hq.shape

    def heads(t):
        return t.astype(jnp.float32).reshape(b_, s_, HGRN_HEADS, HGRN_HEAD_DIM)

    def forget(hf, lb_table):
        lb = jnp.cumsum(jax.nn.softmax(lb_table.astype(jnp.float32), axis=0), axis=0)[layer]
        return heads(lb + (1.0 - lb) * jax.nn.sigmoid(hf.astype(jnp.float32)))

    q = heads(jax.nn.silu(hq.astype(jnp.float32)))
    i = heads(hi)
    f_f = forget(hf_fwd, lb_fwd)
    f_b = forget(hf_bwd, lb_bwd)
    rev = lambda t: jnp.flip(t, axis=1)
    o = hgrn2_chunk_scan(q, f_f, i) + rev(hgrn2_chunk_scan(rev(q), rev(f_b), rev(i)))
    o = o * lax.rsqrt(jnp.mean(jnp.square(o), axis=-1, keepdims=True) + LN_EPS)
    return o.reshape(b_, s_, HGRN_WIDTH) * norm_g * jax.nn.silu(hog.astype(jnp.float32))


def hybrid_mixer(h, w_in, lb_fwd, lb_bwd, layer, hgrn_norm_g, w_a, w_b, w_out):
    proj = h @ w_in
    splits = np.cumsum([HGRN_WIDTH] * 5 + [ATTN_QKV_WIDTH]).tolist()
    hq, hf_fwd, hf_bwd, hi, hog, h_qkv, h_gate = jnp.split(proj, splits, axis=-1)
    y_a = bidirectional_hgrn2(hq, hf_fwd, hf_bwd, hi, hog, lb_fwd, lb_bwd, layer,
                              hgrn_norm_g).astype(h.dtype) @ w_a
    y_b = dilated_attention_mixer(h_qkv).astype(h.dtype) @ w_b
    g_a, g_b = jnp.split(jax.nn.sigmoid(h_gate), N_BRANCHES, axis=-1)
    return (g_a * y_a + g_b * y_b) @ w_out


def setup_inputs(seed: int = 0) -> dict:
    key = jax.random.key(seed)
    ks = jax.random.split(key, 18)

    def normal(k, shape):
        return jax.random.normal(k, shape, jnp.float32)

    def dense(k, shape, scale=1.0):
        return normal(k, shape) * (shape[-2] ** -0.5) * scale

    def gain(k, shape):
        return 1.0 + 0.02 * normal(k, shape)

    def bias(k, shape):
        return 0.02 * normal(k, shape)

    return {
        'x': normal(ks[0], (BATCH, SEQ, D_MODEL)),
        'ffn1_w_in': dense(ks[1], (DEPTH, D_MODEL, 2 * D_FF)),
        'ffn1_w_out': dense(ks[2], (DEPTH, D_FF, D_MODEL), DEEPNORM_BETA),
        'ln1_g': gain(ks[3], (DEPTH, D_MODEL)),
        'ln1_b': bias(ks[4], (DEPTH, D_MODEL)),
        'mix_w_in': dense(ks[5], (DEPTH, D_MODEL, IN_COLS)),
        'hgrn_lb_fwd': 0.1 * normal(ks[6], (DEPTH + 1, HGRN_WIDTH)),
        'hgrn_lb_bwd': 0.1 * normal(ks[7], (DEPTH + 1, HGRN_WIDTH)),
        'hgrn_norm_g': gain(ks[8], (DEPTH, HGRN_WIDTH)),
        'w_branch_a': dense(ks[9], (DEPTH, HGRN_WIDTH, D_MODEL), DEEPNORM_BETA),
        'w_branch_b': dense(ks[10], (DEPTH, ATTN_OUT_WIDTH, D_MODEL), DEEPNORM_BETA),
        'mix_w_out': dense(ks[11], (DEPTH, D_MODEL, D_MODEL), DEEPNORM_BETA),
        'ln2_g': gain(ks[12], (DEPTH, D_MODEL)),
        'ln2_b': bias(ks[13], (DEPTH, D_MODEL)),
        'ffn2_w_in': dense(ks[14], (DEPTH, D_MODEL, 2 * D_FF)),
        'ffn2_w_out': dense(ks[15], (DEPTH, D_FF, D_MODEL), DEEPNORM_BETA),
        'ln3_g': gain(ks[16], (DEPTH, D_MODEL)),
        'ln3_b': bias(ks[17], (DEPTH, D_MODEL)),
    }


def reference(x, ffn1_w_in, ffn1_w_out, ln1_g, ln1_b, mix_w_in, hgrn_lb_fwd, hgrn_lb_bwd,
              hgrn_norm_g, w_branch_a, w_branch_b, mix_w_out, ln2_g, ln2_b,
              ffn2_w_in, ffn2_w_out, ln3_g, ln3_b):
    h = x
    for layer in range(DEPTH):
        h = layer_norm(DEEPNORM_ALPHA * h + 0.5 * swiglu(h, ffn1_w_in[layer], ffn1_w_out[layer]),
                       ln1_g[layer], ln1_b[layer])
        mix = hybrid_mixer(h, mix_w_in[layer], hgrn_lb_fwd, hgrn_lb_bwd, layer, hgrn_norm_g[layer],
                           w_branch_a[layer], w_branch_b[layer], mix_w_out[layer])
        h = layer_norm(DEEPNORM_ALPHA * h + mix, ln2_g[layer], ln2_b[layer])
        h = layer_norm(DEEPNORM_ALPHA * h + 0.5 * swiglu(h, ffn2_w_in[layer], ffn2_w_out[layer]),
                       ln3_g[layer], ln3_b[layer])
    return h
```

```cpp
#include <hip/hip_runtime.h>
#include <hip/hip_cooperative_groups.h>
#include <cstdio>
namespace cg = cooperative_groups;

#define LAS __attribute__((address_space(3)))
typedef unsigned short bf16_t;
typedef short bf16x8 __attribute__((ext_vector_type(8)));
typedef float f32x4 __attribute__((ext_vector_type(4)));
typedef unsigned u32x4 __attribute__((ext_vector_type(4)));
typedef unsigned u32x2 __attribute__((ext_vector_type(2)));

constexpr int SEQ = 2048, NBATCH = 16, MTOK = NBATCH * SEQ, DM = 2048, DFF = 5632, INC = 18944;
constexpr int NHALF = 2, BH = NBATCH / NHALF, MH = BH * SEQ;
constexpr int C_HQ = 0, C_HFF = 2048, C_HFB = 4096, C_HI = 6144, C_HOG = 8192, C_QKV = 10240, C_GA = 14848, C_GB = 16896;
constexpr float LN_EPS = 1e-5f;
constexpr float DN_ALPHA = 1.189207115002721f;

constexpr size_t SZ_WIN = (size_t)2 * DFF * DM * 2, SZ_WOUT = (size_t)DM * DFF * 2, SZ_WMIX = (size_t)INC * DM * 2;
constexpr size_t SZ_WA = (size_t)DM * DM * 2, SZ_WB = (size_t)DM * 512 * 2;
constexpr size_t OFF_W1IN = 0, OFF_W1OUT = OFF_W1IN + SZ_WIN, OFF_WMIX = OFF_W1OUT + SZ_WOUT, OFF_WA = OFF_WMIX + SZ_WMIX, OFF_WB = OFF_WA + SZ_WA,
                 OFF_WO = OFF_WB + SZ_WB, OFF_W2IN = OFF_WO + SZ_WA, OFF_W2OUT = OFF_W2IN + SZ_WIN, OFF_XB = OFF_W2OUT + SZ_WOUT,
                 OFF_PROJ = OFF_XB + (size_t)MTOK * DM * 2, SZ_PROJ = (size_t)MH * INC * 2, OFF_LSE = OFF_PROJ + SZ_PROJ,
                 OFF_ROPE = OFF_LSE + (size_t)3 * MH * 4 * 4, OFF_LB = OFF_ROPE + (size_t)SEQ * 32 * 4, WS_END = OFF_LB + (size_t)2 * DM * 4;
static_assert((size_t)MTOK * DFF * 2 <= SZ_PROJ, "hidden aliases the projection buffer");
constexpr int LDS_BYTES = 147456;

typedef __bf16 bf16x2_t __attribute__((ext_vector_type(2)));
typedef float f32x2_t __attribute__((ext_vector_type(2)));
__device__ __forceinline__ unsigned cvt_pk_bf16(float lo, float hi) { const f32x2_t v = {lo, hi}; const bf16x2_t b = __builtin_convertvector(v, bf16x2_t); return __builtin_bit_cast(unsigned, b); }
__device__ __forceinline__ bf16_t f2bf(float x) { return (bf16_t)(cvt_pk_bf16(x, 0.f) & 0xffffu); }
__device__ __forceinline__ float bf_lo(unsigned w) { return __uint_as_float(w << 16); }
__device__ __forceinline__ float bf_hi(unsigned w) { return __uint_as_float(w & 0xffff0000u); }
__device__ __forceinline__ float bf2f(bf16_t b) { return __uint_as_float(((unsigned)b) << 16); }
__device__ __forceinline__ float sigmoidf_(float x) { return __builtin_amdgcn_rcpf(1.0f + __expf(-x)); }
__device__ __forceinline__ float siluf_(float x) { return x * sigmoidf_(x); }
__device__ __forceinline__ void unpack8(const u32x4 w, float (&f)[8]) {
    f[0] = bf_lo(w.x); f[1] = bf_hi(w.x); f[2] = bf_lo(w.y); f[3] = bf_hi(w.y); f[4] = bf_lo(w.z); f[5] = bf_hi(w.z); f[6] = bf_lo(w.w); f[7] = bf_hi(w.w);
}
__device__ __forceinline__ u32x4 pack8(const float (&f)[8]) {
    u32x4 w; w.x = cvt_pk_bf16(f[0], f[1]); w.y = cvt_pk_bf16(f[2], f[3]); w.z = cvt_pk_bf16(f[4], f[5]); w.w = cvt_pk_bf16(f[6], f[7]); return w;
}
__device__ __forceinline__ float wave_sum(float v) {
#pragma unroll
    for (int o = 1; o < 64; o <<= 1) v += __shfl_xor(v, o);
    return v;
}
#define LDS_WAIT() asm volatile("s_waitcnt lgkmcnt(0)" ::: "memory")
__device__ __forceinline__ int opaque_tid() { int t = threadIdx.x; asm volatile("" : "+v"(t)); return t; }

namespace pg8 {
constexpr int BM = 256, BK = 64, HALF = 128, HTB = HALF * BK * 2, STAGE_BYTES = 8 * HTB, NXCD = 8, WGM = 8;
__host__ __device__ __forceinline__ int lds_byte(int r, int c) { const int st = (r >> 4) * 2 + (c >> 5), rr = r & 15, cc = c & 31, ob = rr * 64 + cc * 2; return st * 1024 + (ob ^ (((ob >> 9) & 1) << 5)); }
__host__ __device__ __forceinline__ void stage_rc(int b, int& R, int& C) { const int st = b / 1024, sb = b % 1024, swz = sb ^ (((sb >> 9) & 1) << 5); R = (st >> 1) * 16 + swz / 64; C = (st & 1) * 32 + (swz % 64) / 2; }
__host__ __device__ __forceinline__ int perm32(int rho) { const int n = rho >> 4, i = rho & 15; return 8 * (i >> 2) + 4 * n + (i & 3); }

struct Unit { int pm, pn; };
struct Gemm { const bf16_t* A; const bf16_t* Bt; int M, N, K, lda; };

struct StaticOrder {
    int nM, nN, nwg, G, c;
    __device__ void init(int M, int N, int G_, int c_) { nM = M / BM; nN = N / BM; nwg = nM * nN; G = G_; c = c_; }
    __device__ bool next(int i, Unit& u) const {
        const long L = (long)i * G + c; if (L >= nwg) return false;
        int wgid = (int)L; { const int q = nwg / NXCD, r = nwg % NXCD, xcd = wgid % NXCD, off = wgid / NXCD; wgid = (xcd < r ? xcd * (q + 1) : r * (q + 1) + (xcd - r) * q) + off; }
        const int nig = WGM * nN, gid = wgid / nig, fm = gid * WGM, gsz = (nM - fm) < WGM ? (nM - fm) : WGM;
        u.pm = fm + ((wgid % nig) % gsz); u.pn = (wgid % nig) / gsz; return true;
    }
};

struct EpiBf16 {
    static constexpr bool PERM = true;
    bf16_t* O; int ldc;
    __device__ __forceinline__ void operator()(const f32x4 (&acc)[2][2][4][2], const Unit& u, int wr, int wc, int fr, int fq) const {
        const int row0 = u.pm * BM + wr * 64 + fr, col0 = u.pn * BM + wc * 32 + 8 * fq;
#pragma unroll
        for (int ai = 0; ai < 2; ++ai)
#pragma unroll
            for (int m = 0; m < 4; ++m) { bf16_t* rowp = O + (size_t)(row0 + ai * HALF + m * 16) * ldc + col0;
#pragma unroll
                for (int bj = 0; bj < 2; ++bj) { const f32x4 v0 = acc[ai][bj][m][0], v1 = acc[ai][bj][m][1];
                    u32x4 w; w.x = cvt_pk_bf16(v0[0], v0[1]); w.y = cvt_pk_bf16(v0[2], v0[3]); w.z = cvt_pk_bf16(v1[0], v1[1]); w.w = cvt_pk_bf16(v1[2], v1[3]);
                    *(u32x4*)(rowp + bj * HALF) = w; } }
    }
};
struct EpiSwiglu {
    static constexpr bool PERM = true;
    bf16_t* O; int ldc;
    __device__ __forceinline__ void operator()(const f32x4 (&acc)[2][2][4][2], const Unit& u, int wr, int wc, int fr, int fq) const {
        const int row0 = u.pm * BM + wr * 64 + fr, col0 = u.pn * HALF + wc * 32 + 8 * fq;
#pragma unroll
        for (int ai = 0; ai < 2; ++ai)
#pragma unroll
            for (int m = 0; m < 4; ++m) { bf16_t* rowp = O + (size_t)(row0 + ai * HALF + m * 16) * ldc + col0;
                float h[8];
#pragma unroll
                for (int n = 0; n < 2; ++n)
#pragma unroll
                    for (int j = 0; j < 4; ++j) h[4 * n + j] = siluf_(acc[ai][0][m][n][j]) * acc[ai][1][m][n][j];
                *(u32x4*)rowp = pack8(h); }
    }
};
struct EpiResF32 {
    static constexpr bool PERM = false;
    const float* res; float* out; int ldc; float alpha, scale;
    __device__ __forceinline__ void operator()(const f32x4 (&acc)[2][2][4][2], const Unit& u, int wr, int wc, int fr, int fq) const {
        const int row0 = u.pm * BM + wr * 64 + fr, col0 = u.pn * BM + wc * 32 + 4 * fq;
#pragma unroll
        for (int ai = 0; ai < 2; ++ai)
#pragma unroll
            for (int m = 0; m < 4; ++m) { const size_t off = (size_t)(row0 + ai * HALF + m * 16) * ldc + col0;
#pragma unroll
                for (int bj = 0; bj < 2; ++bj)
#pragma unroll
                    for (int n = 0; n < 2; ++n) { const size_t o = off + bj * HALF + n * 16; const f32x4 r = *(const f32x4*)(res + o); *(f32x4*)(out + o) = r * alpha + acc[ai][bj][m][n] * scale; } }
    }
};
template <int MODE> struct EpiGate {
    static constexpr bool PERM = true;
    bf16_t* G; int ldc;
    __device__ __forceinline__ void operator()(const f32x4 (&acc)[2][2][4][2], const Unit& u, int wr, int wc, int fr, int fq) const {
        const int row0 = u.pm * BM + wr * 64 + fr, col0 = u.pn * BM + wc * 32 + 8 * fq;
#pragma unroll
        for (int ai = 0; ai < 2; ++ai)
#pragma unroll
            for (int m = 0; m < 4; ++m) { bf16_t* rowp = G + (size_t)(row0 + ai * HALF + m * 16) * ldc + col0;
#pragma unroll
                for (int bj = 0; bj < 2; ++bj) { bf16_t* p = rowp + bj * HALF; float s[8], g[8], o[8];
                    unpack8(*(const u32x4*)p, s);
                    if (MODE == 1) unpack8(*(const u32x4*)(p + 2048), g);
#pragma unroll
                    for (int j = 0; j < 8; ++j) { const float a = acc[ai][bj][m][j >> 2][j & 3]; o[j] = (MODE == 0) ? sigmoidf_(s[j]) * a : s[j] + sigmoidf_(g[j]) * a; }
                    *(u32x4*)p = pack8(o); } }
    }
};

template <class Epi>
__device__ __forceinline__ void gemm_phase(LAS unsigned char* lds, const Gemm g, const StaticOrder& S, const Epi& E) {
    const int tid = opaque_tid(), wid = __builtin_amdgcn_readfirstlane(tid >> 6), lane = tid & 63, wr = wid >> 2, wc = wid & 3, fr = lane & 15, fq = lane >> 4;
    const int K = g.K, nt = K / BK, lda = g.lda;
    unsigned voffA[2], voffB[2];
#pragma unroll
    for (int i = 0; i < 2; ++i) { int R, C; stage_rc(tid * 16 + i * 8192, R, C); const int Rb = Epi::PERM ? ((R & ~31) + perm32(R & 31)) : R;
        voffA[i] = (unsigned)(R * lda + C) * 2u; voffB[i] = (unsigned)(Rb * K + C) * 2u; }
    const size_t kstep = (size_t)(BK * 2);
    const size_t hstepA = (size_t)HALF * lda * 2, hstepB = (size_t)HALF * K * 2;
    const size_t tstepA = 2 * hstepA, tstepB = 2 * hstepB;
    const unsigned ldsw = (unsigned)wid * 1024u;
    const int aoff = lds_byte(wr * 64 + fr, fq * 8), boff = lds_byte(wc * 32 + fr, fq * 8);
#define PG8_SA(b, h) (((b) * 2 + (h)) * HTB)
#define PG8_SB(b, h) ((4 + (b) * 2 + (h)) * HTB)
#define PG8_STAGE(bufoff, gbase, voff) do { _Pragma("unroll") for (int _i = 0; _i < 2; ++_i) \
        __builtin_amdgcn_global_load_lds((const unsigned*)((const char*)(gbase) + (voff)[_i]), (LAS unsigned*)(lds + (bufoff) + ldsw + _i * 8192), 16, 0, 0); } while (0)
#define PG8_LDA(dst, b, h) do { _Pragma("unroll") for (int m = 0; m < 4; ++m) _Pragma("unroll") for (int k = 0; k < 2; ++k) dst[m][k] = *(const LAS bf16x8*)(lds + PG8_SA(b, h) + aoff + m * 2048 + k * 1024); } while (0)
#define PG8_LDB(dst, b, h) do { _Pragma("unroll") for (int n = 0; n < 2; ++n) _Pragma("unroll") for (int k = 0; k < 2; ++k) dst[n][k] = *(const LAS bf16x8*)(lds + PG8_SB(b, h) + boff + n * 2048 + k * 1024); } while (0)
#define PG8_MMA(ai, bj, At, Bt) do { __builtin_amdgcn_s_setprio(1); _Pragma("unroll") for (int m = 0; m < 4; ++m) _Pragma("unroll") for (int n = 0; n < 2; ++n) _Pragma("unroll") for (int k = 0; k < 2; ++k) \
        acc[ai][bj][m][n] = __builtin_amdgcn_mfma_f32_16x16x32_bf16(Bt[n][k], At[m][k], acc[ai][bj][m][n], 0, 0, 0); __builtin_amdgcn_s_setprio(0); } while (0)
#define PG8_WAIT_V(n) asm volatile("s_waitcnt vmcnt(" #n ")" ::: "memory")
#define PG8_WAIT_L(n) asm volatile("s_waitcnt lgkmcnt(" #n ")" ::: "memory")
#define PG8_BAR __builtin_amdgcn_s_barrier()
#define PG8_SCHED __builtin_amdgcn_sched_barrier(0)
    Unit cur, nxt; int ui = 0;
    if (!S.next(0, cur)) return;
    f32x4 acc[2][2][4][2];
#pragma unroll
    for (int a = 0; a < 2; ++a)
#pragma unroll
        for (int b = 0; b < 2; ++b)
#pragma unroll
            for (int m = 0; m < 4; ++m)
#pragma unroll
                for (int n = 0; n < 2; ++n) acc[a][b][m][n] = (f32x4){0.f, 0.f, 0.f, 0.f};
    bf16x8 At[4][2], B0[2][2], B1[2][2];
    const char* cA = (const char*)g.A + (size_t)cur.pm * tstepA; const char* cB = (const char*)g.Bt + (size_t)cur.pn * tstepB;
    PG8_STAGE(PG8_SB(0, 0), cB, voffB); PG8_STAGE(PG8_SA(0, 0), cA, voffA); PG8_STAGE(PG8_SB(0, 1), cB + hstepB, voffB); PG8_STAGE(PG8_SA(0, 1), cA + hstepA, voffA);
    if (wr == 1) PG8_BAR;
    PG8_WAIT_V(4); PG8_BAR;
    PG8_STAGE(PG8_SB(1, 0), cB + kstep, voffB); PG8_STAGE(PG8_SA(1, 0), cA + kstep, voffA); PG8_STAGE(PG8_SB(1, 1), cB + hstepB + kstep, voffB);
    PG8_WAIT_V(6); PG8_BAR;
    for (;;) {
        const bool has_next = S.next(ui + 1, nxt);
        const char* nA = has_next ? (const char*)g.A + (size_t)nxt.pm * tstepA : cA; const char* nB = has_next ? (const char*)g.Bt + (size_t)nxt.pn * tstepB : cB;
        for (int t = 0; t < nt; t += 2) {
            const bool last = (t == nt - 2);
            const char* a1 = cA + (size_t)(t + 1) * kstep;
            const char* a2 = last ? nA : cA + (size_t)(t + 2) * kstep; const char* b2 = last ? nB : cB + (size_t)(t + 2) * kstep;
            const char* a3 = a2 + kstep; const char* b3 = b2 + kstep;
            PG8_LDB(B0, 0, 0); PG8_SCHED; PG8_LDA(At, 0, 0); PG8_STAGE(PG8_SA(1, 1), a1 + hstepA, voffA);
            PG8_WAIT_L(8); PG8_BAR; PG8_WAIT_L(0); PG8_MMA(0, 0, At, B0); PG8_BAR; PG8_SCHED;
            PG8_LDB(B1, 0, 1); PG8_STAGE(PG8_SB(0, 0), b2, voffB);
            PG8_BAR; PG8_WAIT_L(0); PG8_MMA(0, 1, At, B1); PG8_BAR;
            PG8_LDA(At, 0, 1); PG8_STAGE(PG8_SA(0, 0), a2, voffA);
            PG8_BAR; PG8_WAIT_L(0); PG8_MMA(1, 0, At, B0); PG8_BAR; PG8_SCHED;
            PG8_STAGE(PG8_SB(0, 1), b2 + hstepB, voffB);
            PG8_WAIT_V(6); PG8_BAR; PG8_MMA(1, 1, At, B1); PG8_BAR;
            PG8_LDB(B0, 1, 0); PG8_SCHED; PG8_LDA(At, 1, 0); PG8_STAGE(PG8_SA(0, 1), a2 + hstepA, voffA);
            PG8_WAIT_L(8); PG8_BAR; PG8_WAIT_L(0); PG8_MMA(0, 0, At, B0); PG8_BAR; PG8_SCHED;
            PG8_LDB(B1, 1, 1); PG8_STAGE(PG8_SB(1, 0), b3, voffB);
            PG8_BAR; PG8_WAIT_L(0); PG8_MMA(0, 1, At, B1); PG8_BAR;
            PG8_LDA(At, 1, 1); PG8_STAGE(PG8_SA(1, 0), a3, voffA);
            PG8_BAR; PG8_WAIT_L(0); PG8_MMA(1, 0, At, B0); PG8_BAR; PG8_SCHED;
            PG8_STAGE(PG8_SB(1, 1), b3 + hstepB, voffB);
            PG8_WAIT_V(6); PG8_BAR; PG8_MMA(1, 1, At, B1); PG8_BAR;
        }
        E(acc, cur, wr, wc, fr, fq);
        if (!has_next) break;
#pragma unroll
        for (int a = 0; a < 2; ++a)
#pragma unroll
            for (int b = 0; b < 2; ++b)
#pragma unroll
                for (int m = 0; m < 4; ++m)
#pragma unroll
                    for (int n = 0; n < 2; ++n) acc[a][b][m][n] = (f32x4){0.f, 0.f, 0.f, 0.f};
        cur = nxt; cA = nA; cB = nB; ++ui;
    }
    PG8_WAIT_V(0);
    if (wr == 0) PG8_BAR;
    PG8_BAR;
#undef PG8_SA
#undef PG8_SB
#undef PG8_STAGE
#undef PG8_LDA
#undef PG8_LDB
#undef PG8_MMA
#undef PG8_WAIT_V
#undef PG8_WAIT_L
#undef PG8_BAR
#undef PG8_SCHED
}
}

__device__ __forceinline__ void transpose_item(const float* W, int K, int N, bf16_t* WT, LAS float* scr, int item, int lane, int mode) {
    const int nblk = N / 32, kb = item / nblk, nb = item % nblk, k0 = 64 * kb, n0 = 32 * nb;
    int drow0 = n0;
    if (mode == 1) { if (n0 < DFF) drow0 = 256 * (n0 / 128) + (n0 % 128); else { const int n1 = n0 - DFF; drow0 = 256 * (n1 / 128) + 128 + (n1 % 128); } }
#pragma unroll 8
    for (int i = 0; i < 32; ++i) { const int kk = 2 * i + (lane >> 5); scr[kk * 33 + (lane & 31)] = W[(size_t)(k0 + kk) * N + n0 + (lane & 31)]; }
    LDS_WAIT();
    const int c = lane & 7;
#pragma unroll
    for (int j = 0; j < 4; ++j) { const int n = (lane >> 3) + 8 * j; const LAS float* s = scr + (8 * c) * 33 + n;
        u32x4 o; o.x = cvt_pk_bf16(s[0 * 33], s[1 * 33]); o.y = cvt_pk_bf16(s[2 * 33], s[3 * 33]); o.z = cvt_pk_bf16(s[4 * 33], s[5 * 33]); o.w = cvt_pk_bf16(s[6 * 33], s[7 * 33]);
        *(u32x4*)(WT + (size_t)(drow0 + n) * K + k0 + 8 * c) = o; }
    LDS_WAIT();
}

__device__ __forceinline__ void ln_rows(const float* in, float* outf, bf16_t* outb, const float* g, const float* b) {
    const int tid = opaque_tid(), lane = tid & 63, gw = blockIdx.x * 8 + (tid >> 6), ngw = gridDim.x * 8;
    for (int m = gw; m < MTOK; m += ngw) {
        const f32x4* xr = (const f32x4*)(in + (size_t)m * DM) + lane;
        f32x4 v[8]; float s = 0.f;
#pragma unroll
        for (int j = 0; j < 8; ++j) { v[j] = xr[64 * j]; s += (v[j].x + v[j].y) + (v[j].z + v[j].w); }
        const float mean = wave_sum(s) * (1.f / DM); float s2 = 0.f;
#pragma unroll
        for (int j = 0; j < 8; ++j) { v[j] = v[j] - mean; s2 += (v[j].x * v[j].x + v[j].y * v[j].y) + (v[j].z * v[j].z + v[j].w * v[j].w); }
        const float rstd = 1.0f / sqrtf(wave_sum(s2) * (1.f / DM) + LN_EPS);
        f32x4* of = (f32x4*)(outf + (size_t)m * DM) + lane;
#pragma unroll
        for (int j = 0; j < 8; ++j) { const f32x4 gv = ((const f32x4*)g)[lane + 64 * j], bv = ((const f32x4*)b)[lane + 64 * j];
            const f32x4 o = v[j] * rstd * gv + bv; of[64 * j] = o;
            if (outb) { u32x2 w; w.x = cvt_pk_bf16(o.x, o.y); w.y = cvt_pk_bf16(o.z, o.w); *((u32x2*)(outb + (size_t)m * DM) + lane + 64 * j) = w; } }
    }
}

constexpr int HG_LF = 0, HG_DEC = 16384, HG_QD = 16896, HG_KD = HG_QD + 8704, HG_VT = HG_KD + 8704, HG_KET = HG_VT + 10240, HG_AM = HG_KET + 10240, HG_ST = HG_AM + 2560, HG_END = HG_ST + 34816;
static_assert(HG_END <= LDS_BYTES, "hgrn lds");
__device__ __forceinline__ void hgrn_item(LAS unsigned char* lds, bf16_t* proj, const float* lbvec  , int item) {
    const int tid = opaque_tid(), lane = tid & 63, wid = __builtin_amdgcn_readfirstlane(tid >> 6);
    const int dir = item & 1, h = (item >> 1) & 15, bl = item >> 5;
    LAS float* LF = (LAS float*)(lds + HG_LF); LAS float* DEC = (LAS float*)(lds + HG_DEC);
    LAS bf16_t* QD = (LAS bf16_t*)(lds + HG_QD); LAS bf16_t* KD = (LAS bf16_t*)(lds + HG_KD); LAS bf16_t* VT = (LAS bf16_t*)(lds + HG_VT);
    LAS bf16_t* KET = (LAS bf16_t*)(lds + HG_KET); LAS bf16_t* AM = (LAS bf16_t*)(lds + HG_AM); LAS bf16_t* ST = (LAS bf16_t*)(lds + HG_ST);
    const int c = tid >> 4, dg = tid & 15, d0 = 8 * dg;
    const int fcol = dir ? C_HFB : C_HFF;
    float lb[8];
#pragma unroll
    for (int j = 0; j < 8; ++j) lb[j] = lbvec[dir * DM + h * 128 + d0 + j];
    for (int i = tid; i < 34816 / 4; i += 512) ((LAS unsigned*)ST)[i] = 0u;
    f32x4 sacc[8];
#pragma unroll
    for (int i = 0; i < 8; ++i) sacc[i] = (f32x4){0.f, 0.f, 0.f, 0.f};
    const size_t rowbase = (size_t)bl * SEQ;
    const int fr = lane & 15, fq = lane >> 4;
    u32x4 rq, rf, rv;
    { const int t = dir ? (SEQ - 1 - c) : c; const bf16_t* p = proj + (rowbase + t) * INC + h * 128 + d0;
      rq = *(const u32x4*)(p + C_HQ); rf = *(const u32x4*)(p + fcol); rv = *(const u32x4*)(p + C_HI); }
    __syncthreads();
    for (int n = 0; n < SEQ / 32; ++n) {
        float q[8], f[8], v[8], hf[8];
        unpack8(rq, q); unpack8(rf, hf); unpack8(rv, v);
        if (n + 1 < SEQ / 32) { const int tn = dir ? (SEQ - 1 - (32 * (n + 1) + c)) : (32 * (n + 1) + c); const bf16_t* p = proj + (rowbase + tn) * INC + h * 128 + d0;
            rq = *(const u32x4*)(p + C_HQ); rf = *(const u32x4*)(p + fcol); rv = *(const u32x4*)(p + C_HI); }
        f32x4 l0, l1;
#pragma unroll
        for (int j = 0; j < 8; ++j) { q[j] = siluf_(q[j]); f[j] = lb[j] + (1.0f - lb[j]) * sigmoidf_(hf[j]); const float lg = __logf(f[j]); if (j < 4) l0[j] = lg; else l1[j - 4] = lg; }
        *(LAS f32x4*)(LF + c * 128 + d0) = l0; *(LAS f32x4*)(LF + c * 128 + d0 + 4) = l1;
        __syncthreads();
        { const int d = tid & 127, cq = tid >> 7; float run = 0.f;
#pragma unroll
          for (int i = 0; i < 8; ++i) { run += LF[(8 * cq + i) * 128 + d]; LF[(8 * cq + i) * 128 + d] = run; } }
        __syncthreads();
        {
            float cum[8], tot[8];
            { const f32x4 a = *(const LAS f32x4*)(LF + c * 128 + d0), b = *(const LAS f32x4*)(LF + c * 128 + d0 + 4);
#pragma unroll
              for (int j = 0; j < 4; ++j) { cum[j] = a[j]; cum[4 + j] = b[j]; tot[j] = 0.f; tot[4 + j] = 0.f; } }
#pragma unroll
            for (int cq = 0; cq < 4; ++cq) { const f32x4 a = *(const LAS f32x4*)(LF + (8 * cq + 7) * 128 + d0), b = *(const LAS f32x4*)(LF + (8 * cq + 7) * 128 + d0 + 4);
                const bool pre = cq < (c >> 3);
#pragma unroll
                for (int j = 0; j < 4; ++j) { tot[j] += a[j]; tot[4 + j] += b[j]; if (pre) { cum[j] += a[j]; cum[4 + j] += b[j]; } } }
            float qd[8], kd[8], ke[8];
#pragma unroll
            for (int j = 0; j < 8; ++j) { const float k = 1.0f - f[j]; qd[j] = q[j] * __expf(cum[j]); kd[j] = k * __expf(-cum[j]); ke[j] = k * __expf(tot[j] - cum[j]); }
            *(LAS u32x4*)(QD + c * 136 + d0) = pack8(qd); *(LAS u32x4*)(KD + c * 136 + d0) = pack8(kd);
#pragma unroll
            for (int j = 0; j < 8; ++j) { VT[(d0 + j) * 40 + c] = f2bf(v[j]); KET[(d0 + j) * 40 + c] = f2bf(ke[j]); }
            if (c == 0) {
#pragma unroll
                for (int j = 0; j < 8; ++j) DEC[d0 + j] = __expf(tot[j]); }
        }
        __syncthreads();
        if (wid < 4) { const int ct = wid >> 1, st = wid & 1; f32x4 a4 = (f32x4){0.f, 0.f, 0.f, 0.f};
#pragma unroll
            for (int kk = 0; kk < 4; ++kk) { const bf16x8 a = *(const LAS bf16x8*)(QD + (16 * ct + fr) * 136 + 32 * kk + 8 * fq), b = *(const LAS bf16x8*)(KD + (16 * st + fr) * 136 + 32 * kk + 8 * fq);
                a4 = __builtin_amdgcn_mfma_f32_16x16x32_bf16(a, b, a4, 0, 0, 0); }
#pragma unroll
            for (int r = 0; r < 4; ++r) { const int cc = 16 * ct + 4 * fq + r, ss = 16 * st + fr; AM[cc * 40 + ss] = f2bf(ss <= cc ? a4[r] : 0.f); } }
        f32x4 oacc[2];
#pragma unroll
        for (int ct = 0; ct < 2; ++ct) { oacc[ct] = (f32x4){0.f, 0.f, 0.f, 0.f};
#pragma unroll
            for (int kk = 0; kk < 4; ++kk) { const bf16x8 a = *(const LAS bf16x8*)(QD + (16 * ct + fr) * 136 + 32 * kk + 8 * fq), b = *(const LAS bf16x8*)(ST + (16 * wid + fr) * 136 + 32 * kk + 8 * fq);
                oacc[ct] = __builtin_amdgcn_mfma_f32_16x16x32_bf16(a, b, oacc[ct], 0, 0, 0); } }
        __syncthreads();
        const bf16x8 vfrag = *(const LAS bf16x8*)(VT + (16 * wid + fr) * 40 + 8 * fq);
#pragma unroll
        for (int ct = 0; ct < 2; ++ct) { const bf16x8 a = *(const LAS bf16x8*)(AM + (16 * ct + fr) * 40 + 8 * fq);
            oacc[ct] = __builtin_amdgcn_mfma_f32_16x16x32_bf16(a, vfrag, oacc[ct], 0, 0, 0);
#pragma unroll
            for (int r = 0; r < 4; ++r) { const int cc = 16 * ct + 4 * fq + r; const int t = dir ? (SEQ - 1 - (32 * n + cc)) : (32 * n + cc);
                proj[(rowbase + t) * INC + fcol + h * 128 + 16 * wid + fr] = f2bf(oacc[ct][r]); } }
#pragma unroll
        for (int i = 0; i < 8; ++i) { const f32x4 dec = *(const LAS f32x4*)(DEC + 16 * i + 4 * fq);
            const bf16x8 a = *(const LAS bf16x8*)(KET + (16 * i + fr) * 40 + 8 * fq);
            sacc[i] = __builtin_amdgcn_mfma_f32_16x16x32_bf16(a, vfrag, sacc[i] * dec, 0, 0, 0);
            u32x2 w; w.x = cvt_pk_bf16(sacc[i][0], sacc[i][1]); w.y = cvt_pk_bf16(sacc[i][2], sacc[i][3]);
            *(LAS u32x2*)(ST + (16 * wid + fr) * 136 + 16 * i + 4 * fq) = w; }
    }
    __syncthreads();
}

constexpr int AT_QS = 0, AT_KS = 17408, AT_VT = AT_KS + 52224, AT_PS = AT_VT + 53248, AT_END = AT_PS + 4 * 5376;
static_assert(AT_END <= LDS_BYTES, "attn lds");
__device__ __forceinline__ void attn_unit(LAS unsigned char* lds, bf16_t* proj, float* lse, const float* rope, int u) {
    const int tid = opaque_tid(), lane = tid & 63, wid = __builtin_amdgcn_readfirstlane(tid >> 6);
    const int qb = u & 31, hh = (u >> 5) & 3, bl = (u >> 7) & 7, g = u >> 10;
    const int sh = 2 * g, dl = 1 << sh, nblk = 32 >> sh, seg = SEQ >> sh;
    const int r = qb / nblk, n = qb % nblk;
    LAS bf16_t* QS = (LAS bf16_t*)(lds + AT_QS); LAS bf16_t* KS = (LAS bf16_t*)(lds + AT_KS); LAS bf16_t* VT = (LAS bf16_t*)(lds + AT_VT);
    const int qcol = C_QKV + g * 1536 + hh * 128, kcol = qcol + 512, vcol = qcol + 1024;
    const size_t rowbase = (size_t)bl * SEQ;
#pragma unroll
    for (int it = 0; it < 2; ++it) { const int ci = tid + 512 * it, row = ci >> 4, ch = ci & 15; const int pos = (64 * n + row) * dl + r;
        *(LAS u32x4*)(QS + row * 136 + 8 * ch) = *(const u32x4*)(proj + (rowbase + pos) * INC + qcol + 8 * ch); }
#pragma unroll
    for (int it = 0; it < 6; ++it) { const int ci = tid + 512 * it, row = ci >> 4, ch = ci & 15; const int kj = 64 * n - 64 + row; const bool ok = (kj >= 0) && (kj < seg);
        const int pos = ok ? kj * dl + r : 0; const bf16_t* p = proj + (rowbase + pos) * INC;
        u32x4 kv = *(const u32x4*)(p + kcol + 8 * ch), vv = *(const u32x4*)(p + vcol + 8 * ch);
        if (!ok) { kv = (u32x4){0u, 0u, 0u, 0u}; vv = (u32x4){0u, 0u, 0u, 0u}; }
        *(LAS u32x4*)(KS + row * 136 + 8 * ch) = kv;
        LAS bf16_t* vt = VT + (8 * ch) * 208 + row;
        vt[0 * 208] = (bf16_t)(vv.x & 0xffffu); vt[1 * 208] = (bf16_t)(vv.x >> 16); vt[2 * 208] = (bf16_t)(vv.y & 0xffffu); vt[3 * 208] = (bf16_t)(vv.y >> 16);
        vt[4 * 208] = (bf16_t)(vv.z & 0xffffu); vt[5 * 208] = (bf16_t)(vv.z >> 16); vt[6 * 208] = (bf16_t)(vv.w & 0xffffu); vt[7 * 208] = (bf16_t)(vv.w >> 16); }
    __syncthreads();
#pragma unroll
    for (int it = 0; it < 8; ++it) { const int idx = tid + 512 * it, row = idx >> 4, i = idx & 15;
        int pos; LAS bf16_t* p; bool ok = true;
        if (row < 64) { pos = (64 * n + row) * dl + r; p = QS + row * 136; }
        else { const int kj = 64 * n - 64 + (row - 64); ok = (kj >= 0) && (kj < seg); pos = ok ? kj * dl + r : 0; p = KS + (row - 64) * 136; }
        const float cs = rope[pos * 32 + i], sn = rope[pos * 32 + 16 + i];
        const float x1 = bf2f(p[i]), x2 = bf2f(p[16 + i]);
        if (ok) { p[i] = f2bf(x1 * cs - x2 * sn); p[16 + i] = f2bf(x2 * cs + x1 * sn); } }
    __syncthreads();
    if (wid < 4) {
        const int w = wid, fr = lane & 15, fq = lane >> 4;
        LAS bf16_t* PS = (LAS bf16_t*)(lds + AT_PS + w * 5376);
        bf16x8 aq[4];
#pragma unroll
        for (int kk = 0; kk < 4; ++kk) aq[kk] = *(const LAS bf16x8*)(QS + (16 * w + fr) * 136 + 32 * kk + 8 * fq);
        f32x4 s[9];
#pragma unroll
        for (int t = 0; t < 9; ++t) { s[t] = (f32x4){0.f, 0.f, 0.f, 0.f};
#pragma unroll
            for (int kk = 0; kk < 4; ++kk) { const bf16x8 b = *(const LAS bf16x8*)(KS + (16 * (w + t) + fr) * 136 + 32 * kk + 8 * fq);
                s[t] = __builtin_amdgcn_mfma_f32_16x16x32_bf16(aq[kk], b, s[t], 0, 0, 0); } }
        float mx[4] = {-3.0e38f, -3.0e38f, -3.0e38f, -3.0e38f};
#pragma unroll
        for (int t = 0; t < 9; ++t)
#pragma unroll
            for (int rr = 0; rr < 4; ++rr) { const int ql = 16 * w + 4 * fq + rr, jj = 16 * (w + t) + fr; const int kj = 64 * n - 64 + jj; const int dd = ql + 64 - jj;
                const bool ok = (dd <= 64) && (dd >= -64) && (kj >= 0) && (kj < seg);
                const float val = ok ? s[t][rr] * 0.08838834764831845f : -1.0e30f; s[t][rr] = val; mx[rr] = fmaxf(mx[rr], val); }
#pragma unroll
        for (int rr = 0; rr < 4; ++rr) {
#pragma unroll
            for (int o = 1; o < 16; o <<= 1) mx[rr] = fmaxf(mx[rr], __shfl_xor(mx[rr], o)); }
        float sm[4] = {0.f, 0.f, 0.f, 0.f};
#pragma unroll
        for (int t = 0; t < 9; ++t)
#pragma unroll
            for (int rr = 0; rr < 4; ++rr) { const float p = __expf(s[t][rr] - mx[rr]); sm[rr] += p; PS[(4 * fq + rr) * 168 + 16 * t + fr] = f2bf(p); }
#pragma unroll
        for (int rr = 0; rr < 4; ++rr) { PS[(4 * fq + rr) * 168 + 144 + fr] = 0;
#pragma unroll
            for (int o = 1; o < 16; o <<= 1) sm[rr] += __shfl_xor(sm[rr], o); }
        LDS_WAIT();
        f32x4 oacc[8];
#pragma unroll
        for (int nt = 0; nt < 8; ++nt) oacc[nt] = (f32x4){0.f, 0.f, 0.f, 0.f};
#pragma unroll
        for (int kk = 0; kk < 5; ++kk) { const bf16x8 a = *(const LAS bf16x8*)(PS + fr * 168 + 32 * kk + 8 * fq);
#pragma unroll
            for (int nt = 0; nt < 8; ++nt) { const bf16x8 b = *(const LAS bf16x8*)(VT + (16 * nt + fr) * 208 + 16 * w + 32 * kk + 8 * fq);
                oacc[nt] = __builtin_amdgcn_mfma_f32_16x16x32_bf16(a, b, oacc[nt], 0, 0, 0); } }
#pragma unroll
        for (int rr = 0; rr < 4; ++rr) { const int ql = 16 * w + 4 * fq + rr; const int pos = (64 * n + ql) * dl + r; const float inv = 1.0f / sm[rr];
            bf16_t* orow = proj + (rowbase + pos) * INC + qcol;
#pragma unroll
            for (int nt = 0; nt < 8; ++nt) orow[16 * nt + fr] = f2bf(oacc[nt][rr] * inv);
            if (fr == 0) lse[((size_t)g * MH + rowbase + pos) * 4 + hh] = mx[rr] + __logf(sm[rr]); }
    }
    __syncthreads();
}

__device__ __forceinline__ void mixer_finalize(bf16_t* proj, const float* lse, const float* normg) {
    const int tid = opaque_tid(), lane = tid & 63, gw = blockIdx.x * 8 + (tid >> 6), ngw = gridDim.x * 8;
    for (int m = gw; m < MH; m += ngw) {
        bf16_t* row = proj + (size_t)m * INC;
        float o[32]; float ss = 0.f;
#pragma unroll
        for (int j = 0; j < 4; ++j) { float a[8], b[8]; unpack8(*(const u32x4*)(row + C_HFF + 32 * lane + 8 * j), a); unpack8(*(const u32x4*)(row + C_HFB + 32 * lane + 8 * j), b);
#pragma unroll
            for (int k = 0; k < 8; ++k) { const float x = a[k] + b[k]; o[8 * j + k] = x; ss += x * x; } }
        ss += __shfl_xor(ss, 1); ss += __shfl_xor(ss, 2);
        const float rs = 1.0f / sqrtf(ss * (1.f / 128.f) + LN_EPS);
#pragma unroll
        for (int j = 0; j < 4; ++j) { float og[8], res[8]; unpack8(*(const u32x4*)(row + C_HOG + 32 * lane + 8 * j), og);
            const f32x4 g0 = *(const f32x4*)(normg + 32 * lane + 8 * j), g1 = *(const f32x4*)(normg + 32 * lane + 8 * j + 4);
#pragma unroll
            for (int k = 0; k < 8; ++k) res[k] = o[8 * j + k] * rs * (k < 4 ? g0[k] : g1[k - 4]) * siluf_(og[k]);
            *(u32x4*)(row + C_HQ + 32 * lane + 8 * j) = pack8(res); }
        const int hh = lane >> 4, d = 8 * (lane & 15);
        const float l0 = lse[((size_t)0 * MH + m) * 4 + hh], l1 = lse[((size_t)1 * MH + m) * 4 + hh], l2 = lse[((size_t)2 * MH + m) * 4 + hh];
        const float mxl = fmaxf(l0, fmaxf(l1, l2)); float w0 = __expf(l0 - mxl), w1 = __expf(l1 - mxl), w2 = __expf(l2 - mxl); const float iw = 1.0f / (w0 + w1 + w2); w0 *= iw; w1 *= iw; w2 *= iw;
        float a0[8], a1[8], a2[8], res[8];
        unpack8(*(const u32x4*)(row + C_QKV + 0 * 1536 + hh * 128 + d), a0); unpack8(*(const u32x4*)(row + C_QKV + 1 * 1536 + hh * 128 + d), a1); unpack8(*(const u32x4*)(row + C_QKV + 2 * 1536 + hh * 128 + d), a2);
#pragma unroll
        for (int k = 0; k < 8; ++k) res[k] = w0 * a0[k] + w1 * a1[k] + w2 * a2[k];
        *(u32x4*)(row + C_QKV + hh * 128 + d) = pack8(res);
    }
}

__device__ __forceinline__ void grid_barrier(cg::grid_group& grid) {
    __builtin_amdgcn_fence(__ATOMIC_RELEASE, "agent");
    asm volatile("s_waitcnt vmcnt(0) lgkmcnt(0)" ::: "memory");
    grid.sync();
    __builtin_amdgcn_fence(__ATOMIC_ACQUIRE, "agent");
    asm volatile("s_waitcnt vmcnt(0)" ::: "memory");
}
struct Params { const float* in[18]; float* out; unsigned char* ws; };

__global__ void __launch_bounds__(512, 2) fwd_kernel(Params P) {
    extern __shared__ __attribute__((aligned(16))) unsigned char lds_raw[];
    LAS unsigned char* lds = (LAS unsigned char*)lds_raw;
    cg::grid_group grid = cg::this_grid();
    const int G = gridDim.x, bx = blockIdx.x;
    unsigned char* ws = P.ws;
    bf16_t* W1IN = (bf16_t*)(ws + OFF_W1IN); bf16_t* W1OUT = (bf16_t*)(ws + OFF_W1OUT); bf16_t* WMIX = (bf16_t*)(ws + OFF_WMIX);
    bf16_t* WA = (bf16_t*)(ws + OFF_WA); bf16_t* WB = (bf16_t*)(ws + OFF_WB); bf16_t* WO = (bf16_t*)(ws + OFF_WO);
    bf16_t* W2IN = (bf16_t*)(ws + OFF_W2IN); bf16_t* W2OUT = (bf16_t*)(ws + OFF_W2OUT);
    bf16_t* XB = (bf16_t*)(ws + OFF_XB); bf16_t* PROJ = (bf16_t*)(ws + OFF_PROJ); bf16_t* HID = PROJ;
    float* LSE = (float*)(ws + OFF_LSE); float* ROPE = (float*)(ws + OFF_ROPE); float* LB = (float*)(ws + OFF_LB);
    float* OUT = P.out;

    {
        const int tid = opaque_tid(), lane = tid & 63, wave = __builtin_amdgcn_readfirstlane(tid >> 6), gw = bx * 8 + wave, ngw = G * 8;
        LAS float* scr = (LAS float*)(lds + wave * 8448);
        constexpr int I_IN = (DM / 64) * (2 * DFF / 32), I_OUT = (DFF / 64) * (DM / 32), I_MIX = (DM / 64) * (INC / 32), I_A = (DM / 64) * (DM / 32), I_B = (512 / 64) * (DM / 32);
        constexpr int NITEMS = 2 * (I_IN + I_OUT) + I_MIX + 2 * I_A + I_B;
        for (int it = gw; it < NITEMS; it += ngw) {
            int r = it;
            if (r < I_IN) { transpose_item(P.in[1], DM, 2 * DFF, W1IN, scr, r, lane, 1); continue; } r -= I_IN;
            if (r < I_OUT) { transpose_item(P.in[2], DFF, DM, W1OUT, scr, r, lane, 0); continue; } r -= I_OUT;
            if (r < I_MIX) { transpose_item(P.in[5], DM, INC, WMIX, scr, r, lane, 0); continue; } r -= I_MIX;
            if (r < I_A) { transpose_item(P.in[9], DM, DM, WA, scr, r, lane, 0); continue; } r -= I_A;
            if (r < I_B) { transpose_item(P.in[10], 512, DM, WB, scr, r, lane, 0); continue; } r -= I_B;
            if (r < I_A) { transpose_item(P.in[11], DM, DM, WO, scr, r, lane, 0); continue; } r -= I_A;
            if (r < I_IN) { transpose_item(P.in[14], DM, 2 * DFF, W2IN, scr, r, lane, 1); continue; } r -= I_IN;
            transpose_item(P.in[15], DFF, DM, W2OUT, scr, r, lane, 0);
        }
        const size_t nth = (size_t)G * 512, gt = (size_t)bx * 512 + tid;
        const f32x4* x4 = (const f32x4*)P.in[0];
        for (size_t i = gt; i < (size_t)MTOK * DM / 8; i += nth) { const f32x4 a = x4[2 * i], b = x4[2 * i + 1];
            u32x4 w; w.x = cvt_pk_bf16(a.x, a.y); w.y = cvt_pk_bf16(a.z, a.w); w.z = cvt_pk_bf16(b.x, b.y); w.w = cvt_pk_bf16(b.z, b.w); ((u32x4*)XB)[i] = w; }
        for (size_t i = gt; i < (size_t)SEQ * 16; i += nth) { const int pos = (int)(i >> 4), k = (int)(i & 15);
            const float invf = exp2f(-(float)k * (18.931568569324174f / 16.0f));
            const float ang = (float)pos * invf;
            const float kr = rintf(ang * 0.15915494309189535f);
            float rr = fmaf(-kr, 6.2831854820251465f, ang); rr = fmaf(-kr, -1.7484555e-7f, rr);
            ROPE[pos * 32 + k] = cosf(rr); ROPE[pos * 32 + 16 + k] = sinf(rr); }
        for (size_t i = gt; i < (size_t)2 * DM; i += nth) { const int dirr = (int)(i / DM), ch = (int)(i % DM); const float* tb = P.in[6 + dirr];
            LB[i] = 1.0f / (1.0f + expf(tb[DM + ch] - tb[ch])); }
    }
    grid_barrier(grid);

#pragma unroll 1
    for (int f = 0; f < 2; ++f) {
        if (f == 1) {
#pragma unroll 1
            for (int hb = 0; hb < NHALF; ++hb) {
#ifdef SKIP_MIXER
                break;
#endif
                const size_t tok0 = (size_t)hb * MH;
                { pg8::Gemm g{XB + tok0 * DM, WMIX, MH, INC, DM, DM}; pg8::StaticOrder S; S.init(MH, INC, G, bx); pg8::EpiBf16 E{PROJ, INC};
                  pg8::gemm_phase<pg8::EpiBf16>(lds, g, S, E); }
                grid_barrier(grid);
#ifndef SKIP_HGRN
                for (int it = bx; it < BH * 16 * 2; it += G) hgrn_item(lds, PROJ, LB, it);
#endif
                { const int tid = opaque_tid();
                  for (int i = tid; i < 128 * 16; i += 512) { const int rw = i >> 4, cc = i & 15; ((LAS bf16_t*)(lds + AT_VT))[rw * 208 + 192 + cc] = 0; }
                  __syncthreads();
#ifndef SKIP_ATTN
                  for (int u = bx; u < 3 * BH * 4 * 32; u += G) attn_unit(lds, PROJ, LSE, ROPE, u);
#endif
                }
                grid_barrier(grid);
#ifndef SKIP_FIN
                mixer_finalize(PROJ, LSE, P.in[8]);
#endif
                grid_barrier(grid);
                { pg8::Gemm g{PROJ + C_HQ, WA, MH, DM, DM, INC}; pg8::StaticOrder S; S.init(MH, DM, G, bx); pg8::EpiGate<0> E{PROJ + C_GA, INC};
                  pg8::gemm_phase<pg8::EpiGate<0>>(lds, g, S, E); }
                { pg8::Gemm g{PROJ + C_QKV, WB, MH, DM, 512, INC}; pg8::StaticOrder S; S.init(MH, DM, G, bx); pg8::EpiGate<1> E{PROJ + C_GA, INC};
                  pg8::gemm_phase<pg8::EpiGate<1>>(lds, g, S, E); }
                grid_barrier(grid);
                { pg8::Gemm g{PROJ + C_GA, WO, MH, DM, DM, INC}; pg8::StaticOrder S; S.init(MH, DM, G, bx); pg8::EpiResF32 E{OUT + tok0 * DM, OUT + tok0 * DM, DM, DN_ALPHA, 1.0f};
                  pg8::gemm_phase<pg8::EpiResF32>(lds, g, S, E); }
                grid_barrier(grid);
            }
            ln_rows(OUT, OUT, XB, P.in[12], P.in[13]);
            grid_barrier(grid);
        }
        { pg8::Gemm g{XB, f ? W2IN : W1IN, MTOK, 2 * DFF, DM, DM}; pg8::StaticOrder S; S.init(MTOK, 2 * DFF, G, bx); pg8::EpiSwiglu E{HID, DFF};
          pg8::gemm_phase<pg8::EpiSwiglu>(lds, g, S, E); }
        grid_barrier(grid);
        { pg8::Gemm g{HID, f ? W2OUT : W1OUT, MTOK, DM, DFF, DFF}; pg8::StaticOrder S; S.init(MTOK, DM, G, bx); pg8::EpiResF32 E{f ? (const float*)OUT : P.in[0], OUT, DM, DN_ALPHA, 0.5f};
          pg8::gemm_phase<pg8::EpiResF32>(lds, g, S, E); }
        grid_barrier(grid);
        if (f == 0) ln_rows(OUT, OUT, XB, P.in[3], P.in[4]);
        else ln_rows(OUT, OUT, nullptr, P.in[16], P.in[17]);
        if (f == 0) grid_barrier(grid);
    }
}

extern "C" void kernel_launch(void* const* d_in, const int* in_sizes, int n_in, void* d_out, int out_size, void* d_ws, size_t ws_size, hipStream_t stream) {
    static int grid_blocks = 0;
    if (grid_blocks == 0) {
        if (n_in != 18 || ws_size < WS_END) { fprintf(stderr, "kernel_launch: need 18 inputs and >= %zu bytes of workspace; got %d, %zu\n", (size_t)WS_END, n_in, ws_size); grid_blocks = -1; return; }
        int dev = 0, cus = 0, per_cu = 0;
        hipGetDevice(&dev);
        hipDeviceGetAttribute(&cus, hipDeviceAttributeMultiprocessorCount, dev);
        if (hipFuncSetAttribute((const void*)fwd_kernel, hipFuncAttributeMaxDynamicSharedMemorySize, LDS_BYTES) != hipSuccess) fprintf(stderr, "kernel_launch: hipFuncSetAttribute failed\n");
        hipOccupancyMaxActiveBlocksPerMultiprocessor(&per_cu, (const void*)fwd_kernel, 512, LDS_BYTES);
        if (per_cu < 1) { fprintf(stderr, "kernel_launch: occupancy query says %d blocks per CU\n", per_cu); per_cu = 1; }
        (void)hipGetLastError();
        grid_blocks = cus * per_cu;
    }
    if (grid_blocks < 0) return;
#ifdef WS_MEMSET
    (void)hipMemsetAsync(d_ws, 0, WS_END, stream);
#endif
    Params p{};
    for (int i = 0; i < 18; ++i) p.in[i] = (const float*)d_in[i];
    p.out = (float*)d_out; p.ws = (unsigned char*)d_ws;
    void* args[] = {&p};
    hipError_t e = hipLaunchCooperativeKernel((const void*)fwd_kernel, dim3(grid_blocks), dim3(512), args, LDS_BYTES, stream);
    if (e != hipSuccess) fprintf(stderr, "cooperative launch failed: %s (grid %d)\n", hipGetErrorString(e), grid_blocks);
}
```

```cpp
#include <hip/hip_runtime.h>
#include <hip/hip_cooperative_groups.h>
#include <cstdio>
namespace cg = cooperative_groups;

#define LAS __attribute__((address_space(3)))
typedef unsigned short bf16_t;
typedef short bf16x8 __attribute__((ext_vector_type(8)));
typedef float f32x4 __attribute__((ext_vector_type(4)));
typedef unsigned u32x4 __attribute__((ext_vector_type(4)));
typedef unsigned u32x2 __attribute__((ext_vector_type(2)));

constexpr int SEQ = 2048, NBATCH = 16, MTOK = NBATCH * SEQ, DM = 2048, DFF = 5632, INC = 18944;
constexpr int NHALF = 2, BH = NBATCH / NHALF, MH = BH * SEQ;
constexpr int C_HQ = 0, C_HFF = 2048, C_HFB = 4096, C_HI = 6144, C_HOG = 8192, C_QKV = 10240, C_GA = 14848, C_GB = 16896;
constexpr float LN_EPS = 1e-5f;
constexpr float DN_ALPHA = 1.189207115002721f;

constexpr size_t SZ_WIN = (size_t)2 * DFF * DM * 2, SZ_WOUT = (size_t)DM * DFF * 2, SZ_WMIX = (size_t)INC * DM * 2;
constexpr size_t SZ_WA = (size_t)DM * DM * 2, SZ_WB = (size_t)DM * 512 * 2;
constexpr size_t OFF_W1IN = 0, OFF_W1OUT = OFF_W1IN + SZ_WIN, OFF_WMIX = OFF_W1OUT + SZ_WOUT, OFF_WA = OFF_WMIX + SZ_WMIX, OFF_WB = OFF_WA + SZ_WA,
                 OFF_WO = OFF_WB + SZ_WB, OFF_W2IN = OFF_WO + SZ_WA, OFF_W2OUT = OFF_W2IN + SZ_WIN, OFF_XB = OFF_W2OUT + SZ_WOUT,
                 OFF_PROJ = OFF_XB + (size_t)MTOK * DM * 2, SZ_PROJ = (size_t)MH * INC * 2, OFF_LSE = OFF_PROJ + SZ_PROJ,
                 OFF_ROPE = OFF_LSE + (size_t)3 * MH * 4 * 4, OFF_LB = OFF_ROPE + (size_t)SEQ * 32 * 4, WS_END = OFF_LB + (size_t)2 * DM * 4;
static_assert((size_t)MTOK * DFF * 2 + (size_t)MTOK * DM * 2 <= SZ_PROJ, "hidden + FFN branch output alias the projection buffer");
constexpr size_t OFF_BAR = (WS_END + 255) / 256 * 256, BAR_BYTES = 16384, OFF_ATTNC = OFF_BAR + BAR_BYTES, WS_END2 = OFF_ATTNC + (size_t)MH * 512 * 2;
constexpr size_t OFF_OHG = OFF_W1IN;
static_assert((size_t)MH * DM * 2 <= OFF_WMIX - OFF_W1IN, "dense HGRN output must fit in the FFN1 weight region");
constexpr int LDS_BYTES = 147456;

typedef __bf16 bf16x2_t __attribute__((ext_vector_type(2)));
typedef float f32x2_t __attribute__((ext_vector_type(2)));
__device__ __forceinline__ unsigned cvt_pk_bf16(float lo, float hi) { const f32x2_t v = {lo, hi}; const bf16x2_t b = __builtin_convertvector(v, bf16x2_t); return __builtin_bit_cast(unsigned, b); }
__device__ __forceinline__ bf16_t f2bf(float x) { return (bf16_t)(cvt_pk_bf16(x, 0.f) & 0xffffu); }
__device__ __forceinline__ float bf_lo(unsigned w) { return __uint_as_float(w << 16); }
__device__ __forceinline__ float bf_hi(unsigned w) { return __uint_as_float(w & 0xffff0000u); }
__device__ __forceinline__ float bf2f(bf16_t b) { return __uint_as_float(((unsigned)b) << 16); }
__device__ __forceinline__ float sigmoidf_(float x) { return __builtin_amdgcn_rcpf(1.0f + __expf(-x)); }
__device__ __forceinline__ float siluf_(float x) { return x * sigmoidf_(x); }
__device__ __forceinline__ void unpack8(const u32x4 w, float (&f)[8]) {
    f[0] = bf_lo(w.x); f[1] = bf_hi(w.x); f[2] = bf_lo(w.y); f[3] = bf_hi(w.y); f[4] = bf_lo(w.z); f[5] = bf_hi(w.z); f[6] = bf_lo(w.w); f[7] = bf_hi(w.w);
}
__device__ __forceinline__ u32x4 pack8(const float (&f)[8]) {
    u32x4 w; w.x = cvt_pk_bf16(f[0], f[1]); w.y = cvt_pk_bf16(f[2], f[3]); w.z = cvt_pk_bf16(f[4], f[5]); w.w = cvt_pk_bf16(f[6], f[7]); return w;
}
__device__ __forceinline__ float wave_sum(float v) {
#pragma unroll
    for (int o = 1; o < 64; o <<= 1) v += __shfl_xor(v, o);
    return v;
}
#define LDS_WAIT() asm volatile("s_waitcnt lgkmcnt(0)" ::: "memory")
constexpr size_t PTILE = (size_t)MH * 256;
__device__ __forceinline__ size_t pcol(int c) { return (size_t)(c >> 8) * PTILE + (size_t)(c & 255); }
#define BAR_LDS() do { asm volatile("s_waitcnt lgkmcnt(0)" ::: "memory"); __builtin_amdgcn_s_barrier(); asm volatile("" ::: "memory"); } while (0)
__device__ __forceinline__ int opaque_tid() { int t = threadIdx.x; asm volatile("" : "+v"(t)); return t; }

namespace pg8 {
constexpr int BM = 256, BK = 64, HALF = 128, HTB = HALF * BK * 2, STAGE_BYTES = 8 * HTB, NXCD = 8, WGM = 8;
__host__ __device__ __forceinline__ int lds_byte(int r, int c) { const int st = (r >> 4) * 2 + (c >> 5), rr = r & 15, cc = c & 31, ob = rr * 64 + cc * 2; return st * 1024 + (ob ^ (((ob >> 9) & 1) << 5)); }
__host__ __device__ __forceinline__ void stage_rc(int b, int& R, int& C) { const int st = b / 1024, sb = b % 1024, swz = sb ^ (((sb >> 9) & 1) << 5); R = (st >> 1) * 16 + swz / 64; C = (st & 1) * 32 + (swz % 64) / 2; }
__host__ __device__ __forceinline__ int perm32(int rho) { const int n = rho >> 4, i = rho & 15; return 8 * (i >> 2) + 4 * n + (i & 3); }

struct Unit { int pm, pn; };
struct Gemm { const bf16_t* A; const bf16_t* Bt; int M, N, K, lda; };

struct StaticOrder {
    int nM, nN, nwg, G, c, wgm;
    __device__ void init(int M, int N, int G_, int c_, int wgm_ = WGM) { nM = M / BM; nN = N / BM; nwg = nM * nN; G = G_; c = c_; wgm = wgm_; }
    __device__ bool next(int i, Unit& u) const {
        const long L = (long)i * G + c; if (L >= nwg) return false;
        int wgid = (int)L; { const int q = nwg / NXCD, r = nwg % NXCD, xcd = wgid % NXCD, off = wgid / NXCD; wgid = (xcd < r ? xcd * (q + 1) : r * (q + 1) + (xcd - r) * q) + off; }
        const int nig = wgm * nN, gid = wgid / nig, fm = gid * wgm, gsz = (nM - fm) < wgm ? (nM - fm) : wgm;
        u.pm = fm + ((wgid % nig) % gsz); u.pn = (wgid % nig) / gsz; return true;
    }
};

struct EpiBf16 {
    static constexpr bool PERM = true;
    bf16_t* O; size_t tile_elems;
    __device__ __forceinline__ void operator()(const f32x4 (&acc)[2][2][4][2], const Unit& u, int wr, int wc, int fr, int fq) const {
        const int row0 = u.pm * BM + wr * 64 + fr, col0 = wc * 32 + 8 * fq;
#pragma unroll
        for (int ai = 0; ai < 2; ++ai)
#pragma unroll
            for (int m = 0; m < 4; ++m) { bf16_t* rowp = O + (size_t)u.pn * tile_elems + (size_t)(row0 + ai * HALF + m * 16) * 256 + col0;
#pragma unroll
                for (int bj = 0; bj < 2; ++bj) { const f32x4 v0 = acc[ai][bj][m][0], v1 = acc[ai][bj][m][1];
                    u32x4 w; w.x = cvt_pk_bf16(v0[0], v0[1]); w.y = cvt_pk_bf16(v0[2], v0[3]); w.z = cvt_pk_bf16(v1[0], v1[1]); w.w = cvt_pk_bf16(v1[2], v1[3]);
                    *(u32x4*)(rowp + bj * HALF) = w; } }
    }
};
struct EpiScaleBf16 {
    static constexpr bool PERM = true;
    bf16_t* O; int ldc; float scale;
    __device__ __forceinline__ void operator()(const f32x4 (&acc)[2][2][4][2], const Unit& u, int wr, int wc, int fr, int fq) const {
        const int row0 = u.pm * BM + wr * 64 + fr, col0 = u.pn * BM + wc * 32 + 8 * fq;
#pragma unroll
        for (int ai = 0; ai < 2; ++ai)
#pragma unroll
            for (int m = 0; m < 4; ++m) { bf16_t* rowp = O + (size_t)(row0 + ai * HALF + m * 16) * ldc + col0;
#pragma unroll
                for (int bj = 0; bj < 2; ++bj) { const f32x4 v0 = acc[ai][bj][m][0] * scale, v1 = acc[ai][bj][m][1] * scale;
                    u32x4 w; w.x = cvt_pk_bf16(v0[0], v0[1]); w.y = cvt_pk_bf16(v0[2], v0[3]); w.z = cvt_pk_bf16(v1[0], v1[1]); w.w = cvt_pk_bf16(v1[2], v1[3]);
                    *(u32x4*)(rowp + bj * HALF) = w; } }
    }
};
struct EpiSwiglu {
    static constexpr bool PERM = true;
    bf16_t* O; int ldc;
    __device__ __forceinline__ void operator()(const f32x4 (&acc)[2][2][4][2], const Unit& u, int wr, int wc, int fr, int fq) const {
        const int row0 = u.pm * BM + wr * 64 + fr, col0 = u.pn * HALF + wc * 32 + 8 * fq;
#pragma unroll
        for (int ai = 0; ai < 2; ++ai)
#pragma unroll
            for (int m = 0; m < 4; ++m) { bf16_t* rowp = O + (size_t)(row0 + ai * HALF + m * 16) * ldc + col0;
                float h[8];
#pragma unroll
                for (int n = 0; n < 2; ++n)
#pragma unroll
                    for (int j = 0; j < 4; ++j) h[4 * n + j] = siluf_(acc[ai][0][m][n][j]) * acc[ai][1][m][n][j];
                *(u32x4*)rowp = pack8(h); }
    }
};
struct EpiResF32 {
    static constexpr bool PERM = false;
    const float* res; float* out; int ldc; float alpha, scale;
    __device__ __forceinline__ void operator()(const f32x4 (&acc)[2][2][4][2], const Unit& u, int wr, int wc, int fr, int fq) const {
        const int row0 = u.pm * BM + wr * 64 + fr, col0 = u.pn * BM + wc * 32 + 4 * fq;
#pragma unroll
        for (int ai = 0; ai < 2; ++ai)
#pragma unroll
            for (int m = 0; m < 4; ++m) { const size_t off = (size_t)(row0 + ai * HALF + m * 16) * ldc + col0;
#pragma unroll
                for (int bj = 0; bj < 2; ++bj)
#pragma unroll
                    for (int n = 0; n < 2; ++n) { const size_t o = off + bj * HALF + n * 16; const f32x4 r = *(const f32x4*)(res + o); *(f32x4*)(out + o) = r * alpha + acc[ai][bj][m][n] * scale; } }
    }
};
template <int MODE> struct EpiGate {
    static constexpr bool PERM = true;
    const bf16_t* G; size_t tile_elems; bf16_t* O; int ldo;
    __device__ __forceinline__ void operator()(const f32x4 (&acc)[2][2][4][2], const Unit& u, int wr, int wc, int fr, int fq) const {
        const int row0 = u.pm * BM + wr * 64 + fr, col0 = u.pn * BM + wc * 32 + 8 * fq;
#pragma unroll
        for (int ai = 0; ai < 2; ++ai)
#pragma unroll
            for (int m = 0; m < 4; ++m) { const size_t row = (size_t)(row0 + ai * HALF + m * 16);
#pragma unroll
                for (int bj = 0; bj < 2; ++bj) { const bf16_t* gp = G + (size_t)u.pn * tile_elems + row * 256 + (wc * 32 + 8 * fq) + bj * HALF; bf16_t* op = O + row * ldo + col0 + bj * HALF; float s[8], g[8], o[8];
                    unpack8(*(const u32x4*)gp, g);
                    if (MODE == 1) unpack8(*(const u32x4*)op, s);
#pragma unroll
                    for (int j = 0; j < 8; ++j) { const float a = acc[ai][bj][m][j >> 2][j & 3]; o[j] = (MODE == 0) ? sigmoidf_(g[j]) * a : s[j] + sigmoidf_(g[j]) * a; }
                    *(u32x4*)op = pack8(o); } }
    }
};

template <class Epi>
__device__ __forceinline__ void gemm_phase(LAS unsigned char* lds, const Gemm g, const StaticOrder& S, const Epi& E) {
    const int tid = opaque_tid(), wid = __builtin_amdgcn_readfirstlane(tid >> 6), lane = tid & 63, wr = wid >> 2, wc = wid & 3, fr = lane & 15, fq = lane >> 4;
    const int K = g.K, nt = K / BK, lda = g.lda;
    unsigned voffA[2], voffB[2];
#pragma unroll
    for (int i = 0; i < 2; ++i) { int R, C; stage_rc(tid * 16 + i * 8192, R, C); const int Rb = Epi::PERM ? ((R & ~31) + perm32(R & 31)) : R;
        voffA[i] = (unsigned)(R * lda + C) * 2u; voffB[i] = (unsigned)(Rb * K + C) * 2u; }
    const size_t kstep = (size_t)(BK * 2);
    const size_t hstepA = (size_t)HALF * lda * 2, hstepB = (size_t)HALF * K * 2;
    const size_t tstepA = 2 * hstepA, tstepB = 2 * hstepB;
    const unsigned ldsw = (unsigned)wid * 1024u;
    const int aoff = lds_byte(wr * 64 + fr, fq * 8), boff = lds_byte(wc * 32 + fr, fq * 8);
#define PG8_SA(b, h) (((b) * 2 + (h)) * HTB)
#define PG8_SB(b, h) ((4 + (b) * 2 + (h)) * HTB)
#define PG8_STAGE(bufoff, gbase, voff) do { _Pragma("unroll") for (int _i = 0; _i < 2; ++_i) \
        __builtin_amdgcn_global_load_lds((const unsigned*)((const char*)(gbase) + (voff)[_i]), (LAS unsigned*)(lds + (bufoff) + ldsw + _i * 8192), 16, 0, 0); } while (0)
#define PG8_LDA(dst, b, h) do { _Pragma("unroll") for (int m = 0; m < 4; ++m) _Pragma("unroll") for (int k = 0; k < 2; ++k) dst[m][k] = *(const LAS bf16x8*)(lds + PG8_SA(b, h) + aoff + m * 2048 + k * 1024); } while (0)
#define PG8_LDB(dst, b, h) do { _Pragma("unroll") for (int n = 0; n < 2; ++n) _Pragma("unroll") for (int k = 0; k < 2; ++k) dst[n][k] = *(const LAS bf16x8*)(lds + PG8_SB(b, h) + boff + n * 2048 + k * 1024); } while (0)
#define PG8_MMA(ai, bj, At, Bt) do { __builtin_amdgcn_s_setprio(1); _Pragma("unroll") for (int m = 0; m < 4; ++m) _Pragma("unroll") for (int n = 0; n < 2; ++n) _Pragma("unroll") for (int k = 0; k < 2; ++k) \
        acc[ai][bj][m][n] = __builtin_amdgcn_mfma_f32_16x16x32_bf16(Bt[n][k], At[m][k], acc[ai][bj][m][n], 0, 0, 0); __builtin_amdgcn_s_setprio(0); } while (0)
#define PG8_WAIT_V(n) asm volatile("s_waitcnt vmcnt(" #n ")" ::: "memory")
#define PG8_WAIT_L(n) asm volatile("s_waitcnt lgkmcnt(" #n ")" ::: "memory")
#define PG8_BAR __builtin_amdgcn_s_barrier()
#define PG8_SCHED __builtin_amdgcn_sched_barrier(0)
    Unit cur, nxt; int ui = 0;
    if (!S.next(0, cur)) return;
    f32x4 acc[2][2][4][2];
#pragma unroll
    for (int a = 0; a < 2; ++a)
#pragma unroll
        for (int b = 0; b < 2; ++b)
#pragma unroll
            for (int m = 0; m < 4; ++m)
#pragma unroll
                for (int n = 0; n < 2; ++n) acc[a][b][m][n] = (f32x4){0.f, 0.f, 0.f, 0.f};
    bf16x8 At[4][2], B0[2][2], B1[2][2];
    const char* cA = (const char*)g.A + (size_t)cur.pm * tstepA; const char* cB = (const char*)g.Bt + (size_t)cur.pn * tstepB;
    PG8_STAGE(PG8_SB(0, 0), cB, voffB); PG8_STAGE(PG8_SB(0, 1), cB + hstepB, voffB); PG8_STAGE(PG8_SA(0, 0), cA, voffA); PG8_STAGE(PG8_SA(0, 1), cA + hstepA, voffA);
    if (wr == 1) PG8_BAR;
    PG8_WAIT_V(2); PG8_BAR;
    PG8_STAGE(PG8_SB(1, 0), cB + kstep, voffB); PG8_STAGE(PG8_SA(1, 0), cA + kstep, voffA); PG8_STAGE(PG8_SB(1, 1), cB + hstepB + kstep, voffB);
    PG8_WAIT_V(6); PG8_BAR;
    for (;;) {
        const bool has_next = S.next(ui + 1, nxt);
        const char* nA = has_next ? (const char*)g.A + (size_t)nxt.pm * tstepA : cA; const char* nB = has_next ? (const char*)g.Bt + (size_t)nxt.pn * tstepB : cB;
        for (int t = 0; t < nt; t += 2) {
            const bool last = (t == nt - 2);
            const char* a1 = cA + (size_t)(t + 1) * kstep;
            const char* a2 = last ? nA : cA + (size_t)(t + 2) * kstep; const char* b2 = last ? nB : cB + (size_t)(t + 2) * kstep;
            const char* a3 = a2 + kstep; const char* b3 = b2 + kstep;
            PG8_LDB(B0, 0, 0); PG8_LDB(B1, 0, 1); PG8_SCHED; PG8_LDA(At, 0, 0); PG8_STAGE(PG8_SA(1, 1), a1 + hstepA, voffA);
            PG8_WAIT_V(8); PG8_WAIT_L(0); PG8_BAR; PG8_MMA(0, 0, At, B0); PG8_MMA(0, 1, At, B1); PG8_BAR; PG8_SCHED;
            PG8_LDA(At, 0, 1); PG8_STAGE(PG8_SB(0, 0), b2, voffB); PG8_STAGE(PG8_SB(0, 1), b2 + hstepB, voffB); PG8_STAGE(PG8_SA(0, 0), a2, voffA);
            PG8_WAIT_V(8); PG8_WAIT_L(0); PG8_BAR; PG8_MMA(1, 0, At, B0); PG8_MMA(1, 1, At, B1); PG8_BAR; PG8_SCHED;
            PG8_LDB(B0, 1, 0); PG8_LDB(B1, 1, 1); PG8_SCHED; PG8_LDA(At, 1, 0); PG8_STAGE(PG8_SA(0, 1), a2 + hstepA, voffA);
            PG8_WAIT_V(8); PG8_WAIT_L(0); PG8_BAR; PG8_MMA(0, 0, At, B0); PG8_MMA(0, 1, At, B1); PG8_BAR; PG8_SCHED;
            PG8_LDA(At, 1, 1); PG8_STAGE(PG8_SB(1, 0), b3, voffB); PG8_STAGE(PG8_SB(1, 1), b3 + hstepB, voffB); PG8_STAGE(PG8_SA(1, 0), a3, voffA);
            PG8_WAIT_V(8); PG8_WAIT_L(0); PG8_BAR; PG8_MMA(1, 0, At, B0); PG8_MMA(1, 1, At, B1); PG8_BAR; PG8_SCHED;
        }
        if (wr == 0) PG8_BAR;
        E(acc, cur, wr, wc, fr, fq);
        if (!has_next) break;
#pragma unroll
        for (int a = 0; a < 2; ++a)
#pragma unroll
            for (int b = 0; b < 2; ++b)
#pragma unroll
                for (int m = 0; m < 4; ++m)
#pragma unroll
                    for (int n = 0; n < 2; ++n) acc[a][b][m][n] = (f32x4){0.f, 0.f, 0.f, 0.f};
        cur = nxt; cA = nA; cB = nB; ++ui;
        if (wr == 1) PG8_BAR;
    }
    PG8_WAIT_V(0);
    PG8_BAR;
#undef PG8_SA
#undef PG8_SB
#undef PG8_STAGE
#undef PG8_LDA
#undef PG8_LDB
#undef PG8_MMA
#undef PG8_WAIT_V
#undef PG8_WAIT_L
#undef PG8_BAR
#undef PG8_SCHED
}
}

__device__ __forceinline__ void transpose_item(const float* W, int K, int N, bf16_t* WT, LAS float* scr, int item, int lane, int mode) {
    const int nblk = N / 32, kb = item / nblk, nb = item % nblk, k0 = 64 * kb, n0 = 32 * nb;
    int drow0 = n0;
    if (mode == 1) { if (n0 < DFF) drow0 = 256 * (n0 / 128) + (n0 % 128); else { const int n1 = n0 - DFF; drow0 = 256 * (n1 / 128) + 128 + (n1 % 128); } }
#pragma unroll 8
    for (int i = 0; i < 32; ++i) { const int kk = 2 * i + (lane >> 5); scr[kk * 33 + (lane & 31)] = W[(size_t)(k0 + kk) * N + n0 + (lane & 31)]; }
    LDS_WAIT();
    const int c = lane & 7;
#pragma unroll
    for (int j = 0; j < 4; ++j) { const int n = (lane >> 3) + 8 * j; const LAS float* s = scr + (8 * c) * 33 + n;
        u32x4 o; o.x = cvt_pk_bf16(s[0 * 33], s[1 * 33]); o.y = cvt_pk_bf16(s[2 * 33], s[3 * 33]); o.z = cvt_pk_bf16(s[4 * 33], s[5 * 33]); o.w = cvt_pk_bf16(s[6 * 33], s[7 * 33]);
        *(u32x4*)(WT + (size_t)(drow0 + n) * K + k0 + 8 * c) = o; }
    LDS_WAIT();
}

template <bool HB> struct LnIn { };
template <> struct LnIn<false> { f32x4 x[8]; };
template <> struct LnIn<true> { u32x2 x[8]; };
template <bool HB> __device__ __forceinline__ void ln_load(const void* hin, const bf16_t* z, int m, int mm, int lane, LnIn<HB>& r, u32x2 (&zz)[8]) {
    const u32x2* zr = (const u32x2*)(z + (size_t)mm * DM) + lane;
    if constexpr (HB) { const u32x2* xr = (const u32x2*)((const bf16_t*)hin + (size_t)m * DM) + lane;
#pragma unroll
        for (int j = 0; j < 8; ++j) { r.x[j] = xr[64 * j]; zz[j] = zr[64 * j]; } }
    else { const f32x4* xr = (const f32x4*)((const float*)hin + (size_t)m * DM) + lane;
#pragma unroll
        for (int j = 0; j < 8; ++j) { r.x[j] = xr[64 * j]; zz[j] = zr[64 * j]; } }
}
template <bool HB> __device__ __forceinline__ void ln_finish(const LnIn<HB>& r, const u32x2 (&zz)[8], float* outf, bf16_t* outb, const float* g, const float* b, int m, int lane) {
    f32x4 v[8]; float s = 0.f;
#pragma unroll
    for (int j = 0; j < 8; ++j) { f32x4 x;
        if constexpr (HB) x = (f32x4){bf_lo(r.x[j].x), bf_hi(r.x[j].x), bf_lo(r.x[j].y), bf_hi(r.x[j].y)}; else x = r.x[j];
        v[j] = x * DN_ALPHA + (f32x4){bf_lo(zz[j].x), bf_hi(zz[j].x), bf_lo(zz[j].y), bf_hi(zz[j].y)}; s += (v[j].x + v[j].y) + (v[j].z + v[j].w); }
    const float mean = wave_sum(s) * (1.f / DM); float s2 = 0.f;
#pragma unroll
    for (int j = 0; j < 8; ++j) { v[j] = v[j] - mean; s2 += (v[j].x * v[j].x + v[j].y * v[j].y) + (v[j].z * v[j].z + v[j].w * v[j].w); }
    const float rstd = 1.0f / sqrtf(wave_sum(s2) * (1.f / DM) + LN_EPS);
#pragma unroll
    for (int j = 0; j < 8; ++j) { const f32x4 gv = ((const f32x4*)g)[lane + 64 * j], bv = ((const f32x4*)b)[lane + 64 * j];
        const f32x4 o = v[j] * rstd * gv + bv;
        if (outf) ((f32x4*)(outf + (size_t)m * DM) + lane)[64 * j] = o;
        if (outb) { u32x2 w; w.x = cvt_pk_bf16(o.x, o.y); w.y = cvt_pk_bf16(o.z, o.w); *((u32x2*)(outb + (size_t)m * DM) + lane + 64 * j) = w; } }
}
template <bool HB> __device__ __forceinline__ void ln_rows(const void* hin, const bf16_t* z, float* outf, bf16_t* outb, const float* g, const float* b, int row0, int nrows) {
    const int tid = opaque_tid(), lane = tid & 63, gw = blockIdx.x * 8 + (tid >> 6), ngw = gridDim.x * 8;
    LnIn<HB> xa, xb; u32x2 za[8], zb[8];
    int mm = gw;
    if (mm < nrows) ln_load<HB>(hin, z, row0 + mm, mm, lane, xa, za);
    while (mm < nrows) {
        const int m1 = mm + ngw, m2 = m1 + ngw;
        if (m1 < nrows) ln_load<HB>(hin, z, row0 + m1, m1, lane, xb, zb);
        ln_finish<HB>(xa, za, outf, outb, g, b, row0 + mm, lane);
        if (m1 >= nrows) break;
        if (m2 < nrows) ln_load<HB>(hin, z, row0 + m2, m2, lane, xa, za);
        ln_finish<HB>(xb, zb, outf, outb, g, b, row0 + m1, lane);
        mm = m2;
    }
}

constexpr int HG_BUF = 38656, HG_QD = 0, HG_KD = 8832, HG_VT = 17664, HG_KET = 27904, HG_DEC = 38144, HG_ST = 2 * HG_BUF, HG_END = HG_ST + 34816;
__device__ __forceinline__ int hg_row(int r) { return r * 136 + (r >> 3) * 16; }
static_assert(HG_END <= LDS_BYTES, "hgrn lds");
typedef short bf16x4 __attribute__((ext_vector_type(4)));
__device__ __forceinline__ void hgrn_step(LAS unsigned char* lds, const bf16_t* __restrict__ uq, const bf16_t* __restrict__ ufi, bf16_t* __restrict__ ufo, const bf16_t* __restrict__ uv, unsigned voff, unsigned soff, int n, int dir, int wid, int fr, int fq, int d, float lb,
                                          bf16_t (&rq)[8], bf16_t (&rf)[8], bf16_t (&rv)[8], f32x4 (&sacc)[8]) {
    LAS bf16_t* ST = (LAS bf16_t*)(lds + HG_ST);
    {
        LAS unsigned char* B = lds + (n & 1) * HG_BUF;
        LAS bf16_t* QD = (LAS bf16_t*)(B + HG_QD); LAS bf16_t* KD = (LAS bf16_t*)(B + HG_KD); LAS bf16_t* VT = (LAS bf16_t*)(B + HG_VT); LAS bf16_t* KET = (LAS bf16_t*)(B + HG_KET);
        LAS float* DEC = (LAS float*)(B + HG_DEC);
        float q[8], k[8], v[8], cum[8]; float run = 0.f;
#pragma unroll
        for (int i = 0; i < 8; ++i) { q[i] = siluf_(bf2f(rq[i])); const float f = lb + (1.0f - lb) * sigmoidf_(bf2f(rf[i])); k[i] = 1.0f - f; run += __builtin_amdgcn_logf(f); cum[i] = run;     v[i] = bf2f(rv[i]); }
        {
            const int np = (n + 2 < SEQ / 32) ? (n + 2) : (SEQ / 32 - 1);
#pragma unroll
            for (int i = 0; i < 8; ++i) { const int ut = dir ? (SEQ - 1 - 24 - 32 * np - i) : (32 * np + i);
                const size_t ro = (size_t)ut * 256; rq[i] = (uq + ro)[voff]; rf[i] = (ufi + ro)[voff]; rv[i] = (uv + ro)[voff]; } }
        const float T0 = __shfl(run, fr), T1 = __shfl(run, 16 + fr), T2 = __shfl(run, 32 + fr), T3 = __shfl(run, 48 + fr);
        const float pre = (fq > 0 ? T0 : 0.f) + (fq > 1 ? T1 : 0.f) + (fq > 2 ? T2 : 0.f), tot = (T0 + T1) + (T2 + T3);
        float ke[8];
#pragma unroll
        for (int i = 0; i < 8; ++i) { const float c = cum[i] + pre; QD[hg_row(8 * fq + i) + d] = f2bf(q[i] * __builtin_amdgcn_exp2f(c)); KD[hg_row(8 * fq + i) + d] = f2bf(k[i] * __builtin_amdgcn_exp2f(-c)); ke[i] = k[i] * __builtin_amdgcn_exp2f(tot - c); }
        *(LAS u32x4*)(VT + d * 40 + 8 * fq) = pack8(v); *(LAS u32x4*)(KET + d * 40 + 8 * fq) = pack8(ke);
        if (fq == 0) DEC[d] = __builtin_amdgcn_exp2f(tot);
        BAR_LDS();
        const bf16x8 vB = *(const LAS bf16x8*)(VT + (16 * wid + fr) * 40 + 8 * fq);
        const bf16x4 vlo = *(const LAS bf16x4*)(VT + (16 * wid + fr) * 40 + 4 * fq), vhi = *(const LAS bf16x4*)(VT + (16 * wid + fr) * 40 + 16 + 4 * fq);
        const bf16x8 vBp = __builtin_shufflevector(vlo, vhi, 0, 1, 2, 3, 4, 5, 6, 7);
#pragma unroll
        for (int ct = 0; ct < 2; ++ct) {
            bf16x8 qf[4];
#pragma unroll
            for (int kk = 0; kk < 4; ++kk) qf[kk] = *(const LAS bf16x8*)(QD + hg_row(16 * ct + fr) + 32 * kk + 8 * fq);
            f32x4 at0 = (f32x4){0.f, 0.f, 0.f, 0.f}, at1 = (f32x4){0.f, 0.f, 0.f, 0.f};
#pragma unroll
            for (int kk = 0; kk < 4; ++kk) { const bf16x8 kf = *(const LAS bf16x8*)(KD + hg_row(fr) + 32 * kk + 8 * fq); at0 = __builtin_amdgcn_mfma_f32_16x16x32_bf16(kf, qf[kk], at0, 0, 0, 0); }
            if (ct == 1) {
#pragma unroll
                for (int kk = 0; kk < 4; ++kk) { const bf16x8 kf = *(const LAS bf16x8*)(KD + hg_row(16 + fr) + 32 * kk + 8 * fq); at1 = __builtin_amdgcn_mfma_f32_16x16x32_bf16(kf, qf[kk], at1, 0, 0, 0); } }
            const int cc = 16 * ct + fr;
#pragma unroll
            for (int r = 0; r < 4; ++r) { at0[r] = (4 * fq + r <= cc) ? at0[r] : 0.f; at1[r] = (ct == 1 && 16 + 4 * fq + r <= cc) ? at1[r] : 0.f; }
            u32x4 aw; aw.x = cvt_pk_bf16(at0[0], at0[1]); aw.y = cvt_pk_bf16(at0[2], at0[3]); aw.z = cvt_pk_bf16(at1[0], at1[1]); aw.w = cvt_pk_bf16(at1[2], at1[3]);
            const bf16x8 af = __builtin_bit_cast(bf16x8, aw);
            f32x4 o = (f32x4){0.f, 0.f, 0.f, 0.f};
#pragma unroll
            for (int kk = 0; kk < 4; ++kk) { const bf16x8 sf = *(const LAS bf16x8*)(ST + (16 * wid + fr) * 136 + 32 * kk + 8 * fq); o = __builtin_amdgcn_mfma_f32_16x16x32_bf16(qf[kk], sf, o, 0, 0, 0); }
            o = __builtin_amdgcn_mfma_f32_16x16x32_bf16(af, vBp, o, 0, 0, 0);
#pragma unroll
            for (int r = 0; r < 4; ++r) { const int ut = dir ? (SEQ - 1 - 12 - 32 * n - 16 * ct - r) : (32 * n + 16 * ct + r);
                (ufo + (size_t)ut * 256)[soff] = f2bf(o[r]); }
        }
#pragma unroll
        for (int i = 0; i < 8; ++i) { const f32x4 dec = *(const LAS f32x4*)(DEC + 16 * i + 4 * fq);
            const bf16x8 a = *(const LAS bf16x8*)(KET + (16 * i + fr) * 40 + 8 * fq);
            sacc[i] = __builtin_amdgcn_mfma_f32_16x16x32_bf16(a, vB, sacc[i] * dec, 0, 0, 0);
            u32x2 w; w.x = cvt_pk_bf16(sacc[i][0], sacc[i][1]); w.y = cvt_pk_bf16(sacc[i][2], sacc[i][3]);
            *(LAS u32x2*)(ST + (16 * wid + fr) * 136 + 16 * i + 4 * fq) = w; }
    }
}
__device__ __forceinline__ void hgrn_item(LAS unsigned char* lds, bf16_t* proj, const float* lbvec  , int item) {
    const int tid = opaque_tid(), lane = tid & 63, wid = __builtin_amdgcn_readfirstlane(tid >> 6);
    const int slot = (item & 255) >> 3, pair = (slot >> 1) + 16 * (item & 7) + 128 * (item >> 8);
    const int dir = slot & 1, h = pair & 15, bl = pair >> 4;
    const int fr = lane & 15, fq = lane >> 4, d = 16 * wid + fr;
    const int fcol = dir ? C_HFB : C_HFF;
    const float lb = lbvec[dir * DM + h * 128 + d];
    LAS bf16_t* ST = (LAS bf16_t*)(lds + HG_ST);
    for (int i = tid; i < 34816 / 4; i += 512) ((LAS unsigned*)ST)[i] = 0u;
    f32x4 sacc[8];
#pragma unroll
    for (int i = 0; i < 8; ++i) sacc[i] = (f32x4){0.f, 0.f, 0.f, 0.f};
    const size_t rowbase = (size_t)bl * SEQ;
    const bf16_t* uq = proj + pcol(C_HQ + h * 128) - (size_t)(h & 1) * 128 + rowbase * 256; bf16_t* uf = proj + pcol(fcol + h * 128) - (size_t)(h & 1) * 128 + rowbase * 256; const bf16_t* uv = proj + pcol(C_HI + h * 128) - (size_t)(h & 1) * 128 + rowbase * 256;
    const unsigned colw = (unsigned)((h & 1) * 128 + d);
    const unsigned voff = (unsigned)(dir ? (24 - 8 * fq) : 8 * fq) * 256u + colw;
    const unsigned soff = (unsigned)(dir ? (12 - 4 * fq) : 4 * fq) * 256u + colw;
    bf16_t rq[8], rf[8], rv[8], rq1[8], rf1[8], rv1[8];
#pragma unroll
    for (int i = 0; i < 8; ++i) { const int ut = dir ? (SEQ - 1 - 24 - i) : i; const size_t ro = (size_t)ut * 256; rq[i] = (uq + ro)[voff]; rf[i] = (uf + ro)[voff]; rv[i] = (uv + ro)[voff]; }
#pragma unroll
    for (int i = 0; i < 8; ++i) { const int ut = dir ? (SEQ - 1 - 24 - 32 - i) : (32 + i); const size_t ro = (size_t)ut * 256; rq1[i] = (uq + ro)[voff]; rf1[i] = (uf + ro)[voff]; rv1[i] = (uv + ro)[voff]; }
    BAR_LDS();
    for (int n = 0; n < SEQ / 32; n += 2) {
        hgrn_step(lds, uq, uf, uf, uv, voff, soff, n, dir, wid, fr, fq, d, lb, rq, rf, rv, sacc);
        hgrn_step(lds, uq, uf, uf, uv, voff, soff, n + 1, dir, wid, fr, fq, d, lb, rq1, rf1, rv1, sacc);
    }
    BAR_LDS();
}

constexpr int AT_QS = 0, AT_KS = 17408, AT_VT = AT_KS + 52224, AT_PS = AT_VT + 53248, AT_END = AT_PS + 4 * 5376;
static_assert(AT_END <= LDS_BYTES - 16, "attn lds");
struct AttnUnit { int g, hh, dl, seg, r, n, qcol; size_t rowbase; };
__device__ __forceinline__ AttnUnit attn_decode(int i) {
    const int u = (((i >> 8) * 8 + (i & 7)) << 5) + ((i & 255) >> 3);
    AttnUnit A; const int qb = u & 31; A.hh = (u >> 5) & 3; const int bl = (u >> 7) & 7; A.g = u >> 10;
    const int sh = 2 * A.g, nblk = 32 >> sh; A.dl = 1 << sh; A.seg = SEQ >> sh; A.r = qb / nblk; A.n = qb % nblk;
    A.qcol = C_QKV + A.g * 1536 + A.hh * 128; A.rowbase = (size_t)bl * SEQ; return A;
}
__device__ __forceinline__ void attn_load(const bf16_t* proj, const float* rope, const AttnUnit& A, int tid, u32x4 (&qr)[2], u32x4 (&kr)[6], u32x4 (&vr)[6], float (&cs)[8], float (&sn)[8]) {
#pragma unroll
    for (int it = 0; it < 2; ++it) { const int ci = tid + 512 * it, row = ci >> 4, ch = ci & 15; const int pos = (64 * A.n + row) * A.dl + A.r;
        qr[it] = *(const u32x4*)(proj + pcol(A.qcol) + (A.rowbase + pos) * 256 + 8 * ch); }
#pragma unroll
    for (int it = 0; it < 6; ++it) { const int ci = tid + 512 * it, ch = ci / 192, row = ci - 192 * ch; const int kj = 64 * A.n - 64 + row; const bool ok = (kj >= 0) && (kj < A.seg);
        const int pos = ok ? kj * A.dl + A.r : 0; const size_t ro = (A.rowbase + pos) * 256 + 8 * ch;
        kr[it] = *(const u32x4*)(proj + pcol(A.qcol + 512) + ro); vr[it] = *(const u32x4*)(proj + pcol(A.qcol + 1024) + ro); }
#pragma unroll
    for (int it = 0; it < 8; ++it) { const int idx = tid + 512 * it, row = idx >> 4, i = idx & 15; int pos;
        if (row < 64) pos = (64 * A.n + row) * A.dl + A.r; else { const int kj = 64 * A.n - 64 + (row - 64); pos = ((kj >= 0) && (kj < A.seg)) ? kj * A.dl + A.r : 0; }
        cs[it] = rope[pos * 32 + i]; sn[it] = rope[pos * 32 + 16 + i]; }
}
__device__ __forceinline__ void attn_phase(LAS unsigned char* lds, bf16_t* proj, float* lse, const float* rope, int u0, int ustride, int nunits) {
    const int tid = opaque_tid(), lane = tid & 63, wid = __builtin_amdgcn_readfirstlane(tid >> 6);
    LAS bf16_t* QS = (LAS bf16_t*)(lds + AT_QS); LAS bf16_t* KS = (LAS bf16_t*)(lds + AT_KS); LAS bf16_t* VT = (LAS bf16_t*)(lds + AT_VT);
    for (int i = tid; i < 128 * 16; i += 512) { const int rw = i >> 4, cc = i & 15; VT[rw * 208 + 192 + cc] = 0; }
    if (u0 >= nunits) { BAR_LDS(); return; }
    u32x4 qr[2], kr[6], vr[6]; float rcs[8], rsn[8];
    AttnUnit A = attn_decode(u0);
    attn_load(proj, rope, A, tid, qr, kr, vr, rcs, rsn);
    for (int u = u0; u < nunits; u += ustride) {
        const int n = A.n, dl = A.dl, r = A.r, seg = A.seg, hh = A.hh, g = A.g, qcol = A.qcol; const size_t rowbase = A.rowbase;
#pragma unroll
        for (int it = 0; it < 2; ++it) { const int ci = tid + 512 * it, row = ci >> 4, ch = ci & 15; *(LAS u32x4*)(QS + row * 136 + 8 * ch) = qr[it]; }
#pragma unroll
        for (int it = 0; it < 6; ++it) { const int ci = tid + 512 * it, ch = ci / 192, row = ci - 192 * ch; const int kj = 64 * n - 64 + row; const bool ok = (kj >= 0) && (kj < seg);
            u32x4 kv = kr[it], vv = vr[it];
            if (!ok) { kv = (u32x4){0u, 0u, 0u, 0u}; vv = (u32x4){0u, 0u, 0u, 0u}; }
            *(LAS u32x4*)(KS + row * 136 + 8 * ch) = kv;
            LAS bf16_t* vt = VT + (8 * ch) * 208 + row;
            vt[0 * 208] = (bf16_t)(vv.x & 0xffffu); vt[1 * 208] = (bf16_t)(vv.x >> 16); vt[2 * 208] = (bf16_t)(vv.y & 0xffffu); vt[3 * 208] = (bf16_t)(vv.y >> 16);
            vt[4 * 208] = (bf16_t)(vv.z & 0xffffu); vt[5 * 208] = (bf16_t)(vv.z >> 16); vt[6 * 208] = (bf16_t)(vv.w & 0xffffu); vt[7 * 208] = (bf16_t)(vv.w >> 16); }
        float cs[8], sn[8];
#pragma unroll
        for (int it = 0; it < 8; ++it) { cs[it] = rcs[it]; sn[it] = rsn[it]; }
        BAR_LDS();
        if (u + ustride < nunits) { A = attn_decode(u + ustride); attn_load(proj, rope, A, tid, qr, kr, vr, rcs, rsn); }
#pragma unroll
        for (int it = 0; it < 8; ++it) { const int idx = tid + 512 * it, row = idx >> 4, i = idx & 15;
            int pos; LAS bf16_t* p; bool ok = true;
            if (row < 64) { pos = (64 * n + row) * dl + r; p = QS + row * 136; }
            else { const int kj = 64 * n - 64 + (row - 64); ok = (kj >= 0) && (kj < seg); pos = ok ? kj * dl + r : 0; p = KS + (row - 64) * 136; }
            const float x1 = bf2f(p[i]), x2 = bf2f(p[16 + i]);
            if (ok) { p[i] = f2bf(x1 * cs[it] - x2 * sn[it]); p[16 + i] = f2bf(x2 * cs[it] + x1 * sn[it]); } }
        BAR_LDS();
        if (wid < 4) {
            const int w = wid, fr = lane & 15, fq = lane >> 4;
            LAS bf16_t* PS = (LAS bf16_t*)(lds + AT_PS + w * 5376);
            bf16x8 aq[4];
#pragma unroll
            for (int kk = 0; kk < 4; ++kk) aq[kk] = *(const LAS bf16x8*)(QS + (16 * w + fr) * 136 + 32 * kk + 8 * fq);
            f32x4 sc[9];
#pragma unroll
            for (int t = 0; t < 9; ++t) { sc[t] = (f32x4){0.f, 0.f, 0.f, 0.f};
#pragma unroll
                for (int kk = 0; kk < 4; ++kk) { const bf16x8 b = *(const LAS bf16x8*)(KS + (16 * (w + t) + fr) * 136 + 32 * kk + 8 * fq);
                    sc[t] = __builtin_amdgcn_mfma_f32_16x16x32_bf16(aq[kk], b, sc[t], 0, 0, 0); } }
            float mx[4] = {-3.0e38f, -3.0e38f, -3.0e38f, -3.0e38f};
#pragma unroll
            for (int t = 0; t < 9; ++t)
#pragma unroll
                for (int rr = 0; rr < 4; ++rr) { const int ql = 16 * w + 4 * fq + rr, jj = 16 * (w + t) + fr; const int kj = 64 * n - 64 + jj; const int dd = ql + 64 - jj;
                    const bool ok = (dd <= 64) && (dd >= -64) && (kj >= 0) && (kj < seg);
                    const float val = ok ? sc[t][rr] * 0.08838834764831845f : -1.0e30f; sc[t][rr] = val; mx[rr] = fmaxf(mx[rr], val); }
#pragma unroll
            for (int rr = 0; rr < 4; ++rr) {
#pragma unroll
                for (int o = 1; o < 16; o <<= 1) mx[rr] = fmaxf(mx[rr], __shfl_xor(mx[rr], o)); }
            float sm[4] = {0.f, 0.f, 0.f, 0.f};
#pragma unroll
            for (int t = 0; t < 9; ++t)
#pragma unroll
                for (int rr = 0; rr < 4; ++rr) { const float p = __expf(sc[t][rr] - mx[rr]); sm[rr] += p; PS[(4 * fq + rr) * 168 + 16 * t + fr] = f2bf(p); }
#pragma unroll
            for (int rr = 0; rr < 4; ++rr) { PS[(4 * fq + rr) * 168 + 144 + fr] = 0;
#pragma unroll
                for (int o = 1; o < 16; o <<= 1) sm[rr] += __shfl_xor(sm[rr], o); }
            LDS_WAIT();
            f32x4 oacc[8];
#pragma unroll
            for (int nt = 0; nt < 8; ++nt) oacc[nt] = (f32x4){0.f, 0.f, 0.f, 0.f};
#pragma unroll
            for (int kk = 0; kk < 5; ++kk) { const bf16x8 a = *(const LAS bf16x8*)(PS + fr * 168 + 32 * kk + 8 * fq);
#pragma unroll
                for (int nt = 0; nt < 8; ++nt) { const bf16x8 b = *(const LAS bf16x8*)(VT + (16 * nt + fr) * 208 + 16 * w + 32 * kk + 8 * fq);
                    oacc[nt] = __builtin_amdgcn_mfma_f32_16x16x32_bf16(a, b, oacc[nt], 0, 0, 0); } }
#pragma unroll
            for (int rr = 0; rr < 4; ++rr) { const int ql = 16 * w + 4 * fq + rr; const int pos = (64 * n + ql) * dl + r; const float inv = 1.0f / sm[rr];
#pragma unroll
                for (int nt = 0; nt < 8; ++nt) PS[(4 * fq + rr) * 136 + 16 * nt + fr] = f2bf(oacc[nt][rr] * inv);
                if (fr == 0) lse[((size_t)g * MH + rowbase + pos) * 4 + hh] = mx[rr] + __logf(sm[rr]); }
            LDS_WAIT();
#pragma unroll
            for (int k = 0; k < 4; ++k) { const int idx = lane + 64 * k, row = idx >> 4, ch = idx & 15; const int pos = (64 * n + 16 * w + row) * dl + r;
                *(u32x4*)(proj + pcol(qcol) + (rowbase + pos) * 256 + 8 * ch) = *(const LAS u32x4*)(PS + row * 136 + 8 * ch); }
        }
        BAR_LDS();
    }
}

__device__ __forceinline__ void mixer_finalize(bf16_t* proj, const float* lse, const float* normg, bf16_t* ohg, bf16_t* attnc) {
    const int tid = opaque_tid(), lane = tid & 63, gw = blockIdx.x * 8 + (tid >> 6), ngw = gridDim.x * 8;
    for (int m = gw; m < MH; m += ngw) {
        const bf16_t* row = proj + (size_t)m * 256;
        float o[32]; float ss = 0.f;
#pragma unroll
        for (int j = 0; j < 4; ++j) { float a[8], b[8]; unpack8(*(const u32x4*)(row + pcol(C_HFF + 32 * lane + 8 * j)), a); unpack8(*(const u32x4*)(row + pcol(C_HFB + 32 * lane + 8 * j)), b);
#pragma unroll
            for (int k = 0; k < 8; ++k) { const float x = a[k] + b[k]; o[8 * j + k] = x; ss += x * x; } }
        ss += __shfl_xor(ss, 1); ss += __shfl_xor(ss, 2);
        const float rs = 1.0f / sqrtf(ss * (1.f / 128.f) + LN_EPS);
#pragma unroll
        for (int j = 0; j < 4; ++j) { float og[8], res[8]; unpack8(*(const u32x4*)(row + pcol(C_HOG + 32 * lane + 8 * j)), og);
            const f32x4 g0 = *(const f32x4*)(normg + 32 * lane + 8 * j), g1 = *(const f32x4*)(normg + 32 * lane + 8 * j + 4);
#pragma unroll
            for (int k = 0; k < 8; ++k) res[k] = o[8 * j + k] * rs * (k < 4 ? g0[k] : g1[k - 4]) * siluf_(og[k]);
            *(u32x4*)(ohg + (size_t)m * DM + 32 * lane + 8 * j) = pack8(res); }
        const int hh = lane >> 4, d = 8 * (lane & 15);
        const float l0 = lse[((size_t)0 * MH + m) * 4 + hh], l1 = lse[((size_t)1 * MH + m) * 4 + hh], l2 = lse[((size_t)2 * MH + m) * 4 + hh];
        const float mxl = fmaxf(l0, fmaxf(l1, l2)); float w0 = __expf(l0 - mxl), w1 = __expf(l1 - mxl), w2 = __expf(l2 - mxl); const float iw = 1.0f / (w0 + w1 + w2); w0 *= iw; w1 *= iw; w2 *= iw;
        float a0[8], a1[8], a2[8], res[8];
        unpack8(*(const u32x4*)(row + pcol(C_QKV + 0 * 1536 + hh * 128 + d)), a0); unpack8(*(const u32x4*)(row + pcol(C_QKV + 1 * 1536 + hh * 128 + d)), a1); unpack8(*(const u32x4*)(row + pcol(C_QKV + 2 * 1536 + hh * 128 + d)), a2);
#pragma unroll
        for (int k = 0; k < 8; ++k) res[k] = w0 * a0[k] + w1 * a1[k] + w2 * a2[k];
        *(u32x4*)(attnc + (size_t)m * 512 + hh * 128 + d) = pack8(res);
    }
}

#ifndef PROBE_MASK
#define PROBE_MASK 0
#endif
#ifndef PROBE_MODE
#define PROBE_MODE 0
#endif
#define PB_GEMM_FFN 1
#define PB_GEMM_MIX 2
#define PB_HGRN 4
#define PB_ATTN 8
#define PB_FIN 16
#define PB_LN 32
#define PB_PRO 64
#define PB_BAR 128
#define TIC() do { if (PROBE_MASK) { __builtin_amdgcn_s_barrier(); pb_t0 = __builtin_amdgcn_s_memrealtime(); } } while (0)
#define TOC(bit) do { if (PROBE_MASK & (bit)) { __builtin_amdgcn_s_barrier(); pb_acc += __builtin_amdgcn_s_memrealtime() - pb_t0; } } while (0)
#define XB_TMO      128
#define XB_XCNT(j)  (256  + 64 * (j))
#define XB_XSUB(j)  (1280 + 64 * (j))
#define XB_XGEN(j)  (2304 + 64 * (j))
#define XB_TOP      3328
#define XB_TOPGEN   3392
#define XCD_BAR_WORDS 3456
#define XB_SPIN_CAP (1u << 18)
__device__ __forceinline__ unsigned xb_ld(unsigned* p)              { return __hip_atomic_load(p, __ATOMIC_RELAXED, __HIP_MEMORY_SCOPE_AGENT); }
__device__ __forceinline__ unsigned xb_add(unsigned* p, unsigned v) { return __hip_atomic_fetch_add(p, v, __ATOMIC_RELAXED, __HIP_MEMORY_SCOPE_AGENT); }
__device__ __forceinline__ unsigned xb_xcc_id() { return (unsigned)__builtin_amdgcn_s_getreg((3 << 11) | 20) & 0xFu; }
#define XB_SPIN(cond, bar) do { unsigned _sp = 0; while (cond) { __builtin_amdgcn_s_sleep(1); \
    if ((++_sp & 255u) == 0u) { if (xb_ld(&(bar)[XB_TMO])) break; if (_sp > XB_SPIN_CAP) { atomicAdd(&(bar)[XB_TMO], 1u); break; } } } } while (0)
struct XcdBarrier { unsigned* bar; unsigned x; volatile LAS unsigned* st; };
__device__ __forceinline__ XcdBarrier xcd_barrier_post(unsigned* bar, volatile LAS unsigned* st) {
    XcdBarrier b; b.bar = bar; b.x = xb_xcc_id(); b.st = st;
    if (threadIdx.x == 0) (void)xb_add(&bar[XB_XCNT(b.x)], 1u);
    return b;
}
__device__ __forceinline__ void xcd_barrier_complete(unsigned* bar, unsigned x, unsigned& nloc, unsigned& nx) {
    const unsigned G = gridDim.x * gridDim.y * gridDim.z;
    unsigned sum, cnt, mine, sp = 0u;
    for (;;) {
        sum = 0u; cnt = 0u; mine = 0u;
#pragma unroll
        for (unsigned j = 0; j < 16; ++j) { const unsigned c = xb_ld(&bar[XB_XCNT(j)]); sum += c; cnt += (c > 0u) ? 1u : 0u; mine = (j == x) ? c : mine; }
        if (sum == G) break;
        __builtin_amdgcn_s_sleep(1);
        if ((++sp & 255u) == 0u) { if (xb_ld(&bar[XB_TMO])) break; if (sp > XB_SPIN_CAP) { atomicAdd(&bar[XB_TMO], 1u); break; } }
    }
    nloc = mine > 0u ? mine : 1u; nx = cnt > 0u ? cnt : 1u;
}
__device__ __forceinline__ void xcd_barrier(const XcdBarrier& b) {
    asm volatile("s_waitcnt vmcnt(0) lgkmcnt(0)" ::: "memory");
    __syncthreads();
    if (threadIdx.x == 0) {
        unsigned* bar = b.bar;
        __builtin_amdgcn_s_waitcnt(0);
        unsigned nloc = b.st[0], nx = b.st[1];
        if (nloc == 0u) { xcd_barrier_complete(bar, b.x, nloc, nx); b.st[0] = nloc; b.st[1] = nx; }
        const unsigned old = xb_add(&bar[XB_XSUB(b.x)], 1u);
        const unsigned gen = old / nloc;
        if (old + 1u == (gen + 1u) * nloc) {
            __builtin_amdgcn_fence(__ATOMIC_RELEASE, "agent");
            asm volatile("s_waitcnt vmcnt(0)" ::: "memory");
            const unsigned og = xb_add(&bar[XB_TOP], 1u);
            const unsigned tg = og / nx;
            if (og + 1u == (tg + 1u) * nx) xb_add(&bar[XB_TOPGEN], 1u);
            else XB_SPIN(xb_ld(&bar[XB_TOPGEN]) == tg, bar);
            __builtin_amdgcn_fence(__ATOMIC_ACQUIRE, "agent");
            xb_add(&bar[XB_XGEN(b.x)], 1u);
            asm volatile("s_waitcnt vmcnt(0)" ::: "memory");
        } else {
            XB_SPIN(xb_ld(&bar[XB_XGEN(b.x)]) == gen, bar);
            __builtin_amdgcn_fence(__ATOMIC_ACQUIRE, "agent");
            asm volatile("s_waitcnt vmcnt(0)" ::: "memory");
        }
    }
    __syncthreads();
    asm volatile("" ::: "memory");
}
__device__ __forceinline__ void grid_barrier_ctr(unsigned* cnt, unsigned& target, unsigned nblk) {
    asm volatile("s_waitcnt vmcnt(0) lgkmcnt(0)" ::: "memory");
    __builtin_amdgcn_s_barrier();
    target += nblk;
    if (threadIdx.x == 0) {
        __builtin_amdgcn_fence(__ATOMIC_RELEASE, "agent");
        asm volatile("s_waitcnt vmcnt(0)" ::: "memory");
        __hip_atomic_fetch_add(cnt, 1u, __ATOMIC_RELAXED, __HIP_MEMORY_SCOPE_AGENT);
        while (__hip_atomic_load(cnt, __ATOMIC_RELAXED, __HIP_MEMORY_SCOPE_AGENT) < target) __builtin_amdgcn_s_sleep(1);
        __builtin_amdgcn_fence(__ATOMIC_ACQUIRE, "agent");
        asm volatile("s_waitcnt vmcnt(0)" ::: "memory");
    }
    __builtin_amdgcn_s_barrier();
    asm volatile("" ::: "memory");
}
__device__ __forceinline__ void grid_barrier(cg::grid_group& grid) {
    asm volatile("s_waitcnt vmcnt(0) lgkmcnt(0)" ::: "memory");
    grid.sync();
    asm volatile("" ::: "memory");
}
struct Params { const float* in[18]; float* out; unsigned char* ws; };

__global__ void __launch_bounds__(512, 2) fwd_kernel(Params P) {
    extern __shared__ __attribute__((aligned(16))) unsigned char lds_raw[];
    LAS unsigned char* lds = (LAS unsigned char*)lds_raw;
    cg::grid_group grid = cg::this_grid();
    const int G = gridDim.x, bx = blockIdx.x;
    unsigned long long pb_t0 = 0, pb_acc = 0;
    unsigned* BARCNT = (unsigned*)(P.ws + OFF_BAR); unsigned bar_target = 0;
    volatile LAS unsigned* xb_st = (volatile LAS unsigned*)(lds + LDS_BYTES - 16);
    if (threadIdx.x == 0) { xb_st[0] = 0u; xb_st[1] = 0u; }
    __syncthreads();
    const XcdBarrier xbar = xcd_barrier_post(BARCNT, xb_st);
    unsigned char* ws = P.ws;
    bf16_t* W1IN = (bf16_t*)(ws + OFF_W1IN); bf16_t* W1OUT = (bf16_t*)(ws + OFF_W1OUT); bf16_t* WMIX = (bf16_t*)(ws + OFF_WMIX);
    bf16_t* WA = (bf16_t*)(ws + OFF_WA); bf16_t* WB = (bf16_t*)(ws + OFF_WB); bf16_t* WO = (bf16_t*)(ws + OFF_WO);
    bf16_t* W2IN = (bf16_t*)(ws + OFF_W2IN); bf16_t* W2OUT = (bf16_t*)(ws + OFF_W2OUT);
    bf16_t* XB = (bf16_t*)(ws + OFF_XB); bf16_t* PROJ = (bf16_t*)(ws + OFF_PROJ); bf16_t* HID = PROJ;
    float* LSE = (float*)(ws + OFF_LSE); float* ROPE = (float*)(ws + OFF_ROPE); float* LB = (float*)(ws + OFF_LB);
    float* OUT = P.out;
    bf16_t* OHG = (bf16_t*)(ws + OFF_OHG); bf16_t* ATTNC = (bf16_t*)(ws + OFF_ATTNC);
    bf16_t* ZF = (bf16_t*)(ws + OFF_PROJ + (size_t)MTOK * DFF * 2);
    bf16_t* ZM = OHG;

    TIC();
    {
        const int tid = opaque_tid(), lane = tid & 63, wave = __builtin_amdgcn_readfirstlane(tid >> 6), gw = bx * 8 + wave, ngw = G * 8;
        LAS float* scr = (LAS float*)(lds + wave * 8448);
        constexpr int I_IN = (DM / 64) * (2 * DFF / 32), I_OUT = (DFF / 64) * (DM / 32), I_MIX = (DM / 64) * (INC / 32), I_A = (DM / 64) * (DM / 32), I_B = (512 / 64) * (DM / 32);
        constexpr int NITEMS = 2 * (I_IN + I_OUT) + I_MIX + 2 * I_A + I_B;
        for (int it = gw; it < NITEMS; it += ngw) {
            int r = it;
            if (r < I_IN) { transpose_item(P.in[1], DM, 2 * DFF, W1IN, scr, r, lane, 1); continue; } r -= I_IN;
            if (r < I_OUT) { transpose_item(P.in[2], DFF, DM, W1OUT, scr, r, lane, 0); continue; } r -= I_OUT;
            if (r < I_MIX) { transpose_item(P.in[5], DM, INC, WMIX, scr, r, lane, 0); continue; } r -= I_MIX;
            if (r < I_A) { transpose_item(P.in[9], DM, DM, WA, scr, r, lane, 0); continue; } r -= I_A;
            if (r < I_B) { transpose_item(P.in[10], 512, DM, WB, scr, r, lane, 0); continue; } r -= I_B;
            if (r < I_A) { transpose_item(P.in[11], DM, DM, WO, scr, r, lane, 0); continue; } r -= I_A;
            if (r < I_IN) { transpose_item(P.in[14], DM, 2 * DFF, W2IN, scr, r, lane, 1); continue; } r -= I_IN;
            transpose_item(P.in[15], DFF, DM, W2OUT, scr, r, lane, 0);
        }
        const size_t nth = (size_t)G * 512, gt = (size_t)bx * 512 + tid;
        const f32x4* x4 = (const f32x4*)P.in[0];
        for (size_t i = gt; i < (size_t)MTOK * DM / 8; i += nth) { const f32x4 a = x4[2 * i], b = x4[2 * i + 1];
            u32x4 w; w.x = cvt_pk_bf16(a.x, a.y); w.y = cvt_pk_bf16(a.z, a.w); w.z = cvt_pk_bf16(b.x, b.y); w.w = cvt_pk_bf16(b.z, b.w); ((u32x4*)XB)[i] = w; }
        for (size_t i = gt; i < (size_t)SEQ * 16; i += nth) { const int pos = (int)(i >> 4), k = (int)(i & 15);
            const float invf = exp2f(-(float)k * (18.931568569324174f / 16.0f));
            const float ang = (float)pos * invf;
            const float kr = rintf(ang * 0.15915494309189535f);
            float rr = fmaf(-kr, 6.2831854820251465f, ang); rr = fmaf(-kr, -1.7484555e-7f, rr);
            ROPE[pos * 32 + k] = cosf(rr); ROPE[pos * 32 + 16 + k] = sinf(rr); }
        for (size_t i = gt; i < (size_t)2 * DM; i += nth) { const int dirr = (int)(i / DM), ch = (int)(i % DM); const float* tb = P.in[6 + dirr];
            LB[i] = 1.0f / (1.0f + expf(tb[DM + ch] - tb[ch])); }
    }
    TOC(PB_PRO);
    { TIC(); grid_barrier(grid); TOC(PB_BAR); }

#pragma unroll 1
    for (int f = 0; f < 2; ++f) {
        if (f == 1) {
#pragma unroll 1
            for (int hb = 0; hb < NHALF; ++hb) {
#ifdef SKIP_MIXER
                break;
#endif
                const size_t tok0 = (size_t)hb * MH;
                TIC();
                { pg8::Gemm g{XB + tok0 * DM, WMIX, MH, INC, DM, DM}; pg8::StaticOrder S; S.init(MH, INC, G, bx); pg8::EpiBf16 E{PROJ, PTILE};
                  pg8::gemm_phase<pg8::EpiBf16>(lds, g, S, E); }
                TOC(PB_GEMM_MIX);
                { TIC(); xcd_barrier(xbar); TOC(PB_BAR); }
                TIC();
#pragma unroll 1
                for (int pass = 0; pass < 2; ++pass) {
                    if ((pass == 0) == ((bx & 4) == 0)) { for (int it = bx; it < BH * 16 * 2; it += G) hgrn_item(lds, PROJ, LB, it); }
                    else attn_phase(lds, PROJ, LSE, ROPE, bx, G, 3 * BH * 4 * 32);
                }
                TOC(PB_HGRN);
                { TIC(); xcd_barrier(xbar); TOC(PB_BAR); }
                TIC();
#ifndef SKIP_FIN
                mixer_finalize(PROJ, LSE, P.in[8], OHG, ATTNC);
#endif
                TOC(PB_FIN);
                { TIC(); xcd_barrier(xbar); TOC(PB_BAR); }
                TIC();
                bf16_t* MIXB = PROJ;
                { pg8::Gemm g{OHG, WA, MH, DM, DM, DM}; pg8::StaticOrder S; S.init(MH, DM, G, bx, 4); pg8::EpiGate<0> E{PROJ + pcol(C_GA), PTILE, MIXB, DM};
                  pg8::gemm_phase<pg8::EpiGate<0>>(lds, g, S, E); }
                { pg8::Gemm g{ATTNC, WB, MH, DM, 512, 512}; pg8::StaticOrder S; S.init(MH, DM, G, bx, 4); pg8::EpiGate<1> E{PROJ + pcol(C_GB), PTILE, MIXB, DM};
                  pg8::gemm_phase<pg8::EpiGate<1>>(lds, g, S, E); }
                TOC(PB_GEMM_MIX);
                { TIC(); xcd_barrier(xbar); TOC(PB_BAR); }
                TIC();
                { pg8::Gemm g{MIXB, WO, MH, DM, DM, DM}; pg8::StaticOrder S; S.init(MH, DM, G, bx, 4); pg8::EpiScaleBf16 E{ZM, DM, 1.0f};
                  pg8::gemm_phase<pg8::EpiScaleBf16>(lds, g, S, E); }
                TOC(PB_GEMM_MIX);
                { TIC(); xcd_barrier(xbar); TOC(PB_BAR); }
                TIC();
                ln_rows<true>(XB, ZM, nullptr, XB, P.in[12], P.in[13], (int)tok0, MH);
                TOC(PB_LN);
                if (hb == NHALF - 1) { TIC(); xcd_barrier(xbar); TOC(PB_BAR); }
            }
        }
        TIC();
        { pg8::Gemm g{XB, f ? W2IN : W1IN, MTOK, 2 * DFF, DM, DM}; pg8::StaticOrder S; S.init(MTOK, 2 * DFF, G, bx); pg8::EpiSwiglu E{HID, DFF};
          pg8::gemm_phase<pg8::EpiSwiglu>(lds, g, S, E); }
        TOC(PB_GEMM_FFN);
        { TIC(); xcd_barrier(xbar); TOC(PB_BAR); }
        TIC();
        { pg8::Gemm g{HID, f ? W2OUT : W1OUT, MTOK, DM, DFF, DFF}; pg8::StaticOrder S; S.init(MTOK, DM, G, bx, 4); pg8::EpiScaleBf16 E{ZF, DM, 0.5f};
          pg8::gemm_phase<pg8::EpiScaleBf16>(lds, g, S, E); }
        TOC(PB_GEMM_FFN);
        { TIC(); xcd_barrier(xbar); TOC(PB_BAR); }
        TIC();
        if (f == 0) ln_rows<false>(P.in[0], ZF, nullptr, XB, P.in[3], P.in[4], 0, MTOK);
        else ln_rows<true>(XB, ZF, OUT, nullptr, P.in[16], P.in[17], 0, MTOK);
        TOC(PB_LN);
        if (f == 0) { TIC(); xcd_barrier(xbar); TOC(PB_BAR); }
    }
    if (PROBE_MASK) {
        unsigned long long* pw = (unsigned long long*)(P.ws + OFF_BAR + 64);
        if (PROBE_MODE != 0) {
            if (threadIdx.x == 0) atomicMax(pw, PROBE_MODE == 1 ? pb_acc : ((1ull << 40) - pb_acc));
            grid_barrier_ctr(BARCNT, bar_target, (unsigned)G);
            if (threadIdx.x == 0) { const unsigned long long v = __hip_atomic_load(pw, __ATOMIC_RELAXED, __HIP_MEMORY_SCOPE_AGENT); pb_acc = PROBE_MODE == 1 ? v : ((1ull << 40) - v); }
        }
        if (bx == 0 && threadIdx.x == 0) { const unsigned long long t1 = __builtin_amdgcn_s_memrealtime(); while (__builtin_amdgcn_s_memrealtime() - t1 < pb_acc) __builtin_amdgcn_s_sleep(8); }
    }
}

extern "C" void kernel_launch(void* const* d_in, const int* in_sizes, int n_in, void* d_out, int out_size, void* d_ws, size_t ws_size, hipStream_t stream) {
    static int grid_blocks = 0;
    if (grid_blocks == 0) {
        if (n_in != 18 || ws_size < WS_END2) { fprintf(stderr, "kernel_launch: need 18 inputs and >= %zu bytes of workspace; got %d, %zu\n", (size_t)WS_END2, n_in, ws_size); grid_blocks = -1; return; }
        int dev = 0, cus = 0, per_cu = 0;
        hipGetDevice(&dev);
        hipDeviceGetAttribute(&cus, hipDeviceAttributeMultiprocessorCount, dev);
        if (hipFuncSetAttribute((const void*)fwd_kernel, hipFuncAttributeMaxDynamicSharedMemorySize, LDS_BYTES) != hipSuccess) fprintf(stderr, "kernel_launch: hipFuncSetAttribute failed\n");
        hipOccupancyMaxActiveBlocksPerMultiprocessor(&per_cu, (const void*)fwd_kernel, 512, LDS_BYTES);
        if (per_cu < 1) { fprintf(stderr, "kernel_launch: occupancy query says %d blocks per CU\n", per_cu); per_cu = 1; }
        (void)hipGetLastError();
        grid_blocks = cus * per_cu;
    }
    if (grid_blocks < 0) return;
    (void)hipMemsetAsync((char*)d_ws + OFF_BAR, 0, BAR_BYTES, stream);
    Params p{};
    for (int i = 0; i < 18; ++i) p.in[i] = (const float*)d_in[i];
    p.out = (float*)d_out; p.ws = (unsigned char*)d_ws;
    void* args[] = {&p};
    hipError_t e = hipLaunchCooperativeKernel((const void*)fwd_kernel, dim3(grid_blocks), dim3(512), args, LDS_BYTES, stream);
    if (e != hipSuccess) fprintf(stderr, "cooperative launch failed: %s (grid %d)\n", hipGetErrorString(e), grid_blocks);
}
```

```cpp
#include <hip/hip_runtime.h>
#include <hip/hip_cooperative_groups.h>
#include <cstdio>
namespace cg = cooperative_groups;

#define LAS __attribute__((address_space(3)))
typedef unsigned short bf16_t;
typedef short bf16x8 __attribute__((ext_vector_type(8)));
typedef float f32x4 __attribute__((ext_vector_type(4)));
typedef unsigned u32x4 __attribute__((ext_vector_type(4)));
typedef unsigned u32x2 __attribute__((ext_vector_type(2)));

constexpr int SEQ = 2048, NBATCH = 16, MTOK = NBATCH * SEQ, DM = 2048, DFF = 5632, INC = 18944;
constexpr int NHALF = 2, BH = NBATCH / NHALF, MH = BH * SEQ;
constexpr int C_HQ = 0, C_HFF = 2048, C_HFB = 4096, C_HI = 6144, C_HOG = 8192, C_QKV = 10240, C_GA = 14848, C_GB = 16896;
constexpr float LN_EPS = 1e-5f;
constexpr float DN_ALPHA = 1.189207115002721f;

constexpr size_t SZ_WIN = (size_t)2 * DFF * DM * 2, SZ_WOUT = (size_t)DM * DFF * 2, SZ_WMIX = (size_t)INC * DM * 2;
constexpr size_t SZ_WA = (size_t)DM * DM * 2, SZ_WB = (size_t)DM * 512 * 2;
constexpr size_t OFF_W1IN = 0, OFF_W1OUT = OFF_W1IN + SZ_WIN, OFF_WMIX = OFF_W1OUT + SZ_WOUT, OFF_WA = OFF_WMIX + SZ_WMIX, OFF_WB = OFF_WA + SZ_WA,
                 OFF_WO = OFF_WB + SZ_WB, OFF_W2IN = OFF_WO + SZ_WA, OFF_W2OUT = OFF_W2IN + SZ_WIN, OFF_XB = OFF_W2OUT + SZ_WOUT,
                 OFF_PROJ = OFF_XB + (size_t)MTOK * DM * 2, SZ_PROJ = (size_t)MH * INC * 2, OFF_LSE = OFF_PROJ + SZ_PROJ,
                 OFF_ROPE = OFF_LSE + (size_t)3 * MH * 4 * 4, OFF_LB = OFF_ROPE + (size_t)SEQ * 32 * 4, WS_END = OFF_LB + (size_t)2 * DM * 4;
static_assert((size_t)MTOK * DFF * 2 + (size_t)MTOK * DM * 2 <= SZ_PROJ, "hidden + FFN branch output alias the projection buffer");
constexpr size_t OFF_BAR = (WS_END + 255) / 256 * 256, BAR_BYTES = 16384, OFF_ATTNC = OFF_BAR + BAR_BYTES, WS_END2 = OFF_ATTNC + (size_t)MH * 512 * 2;
constexpr size_t OFF_OHG = OFF_W1IN;
static_assert((size_t)MH * DM * 2 <= OFF_WMIX - OFF_W1IN, "dense HGRN output must fit in the FFN1 weight region");
constexpr int LDS_BYTES = 147456;

typedef __bf16 bf16x2_t __attribute__((ext_vector_type(2)));
typedef float f32x2_t __attribute__((ext_vector_type(2)));
__device__ __forceinline__ unsigned cvt_pk_bf16(float lo, float hi) { const f32x2_t v = {lo, hi}; const bf16x2_t b = __builtin_convertvector(v, bf16x2_t); return __builtin_bit_cast(unsigned, b); }
__device__ __forceinline__ bf16_t f2bf(float x) { return (bf16_t)(cvt_pk_bf16(x, 0.f) & 0xffffu); }
__device__ __forceinline__ float bf_lo(unsigned w) { return __uint_as_float(w << 16); }
__device__ __forceinline__ float bf_hi(unsigned w) { return __uint_as_float(w & 0xffff0000u); }
__device__ __forceinline__ float bf2f(bf16_t b) { return __uint_as_float(((unsigned)b) << 16); }
__device__ __forceinline__ float sigmoidf_(float x) { return __builtin_amdgcn_rcpf(1.0f + __expf(-x)); }
__device__ __forceinline__ float siluf_(float x) { return x * sigmoidf_(x); }
__device__ __forceinline__ void unpack8(const u32x4 w, float (&f)[8]) {
    f[0] = bf_lo(w.x); f[1] = bf_hi(w.x); f[2] = bf_lo(w.y); f[3] = bf_hi(w.y); f[4] = bf_lo(w.z); f[5] = bf_hi(w.z); f[6] = bf_lo(w.w); f[7] = bf_hi(w.w);
}
__device__ __forceinline__ u32x4 pack8(const float (&f)[8]) {
    u32x4 w; w.x = cvt_pk_bf16(f[0], f[1]); w.y = cvt_pk_bf16(f[2], f[3]); w.z = cvt_pk_bf16(f[4], f[5]); w.w = cvt_pk_bf16(f[6], f[7]); return w;
}
__device__ __forceinline__ float wave_sum(float v) {
#pragma unroll
    for (int o = 1; o < 64; o <<= 1) v += __shfl_xor(v, o);
    return v;
}
#define LDS_WAIT() asm volatile("s_waitcnt lgkmcnt(0)" ::: "memory")
constexpr size_t PTILE = (size_t)MH * 256;
__device__ __forceinline__ size_t pcol(int c) { return (size_t)(c >> 8) * PTILE + (size_t)(c & 255); }
#define BAR_LDS() do { asm volatile("s_waitcnt lgkmcnt(0)" ::: "memory"); __builtin_amdgcn_s_barrier(); asm volatile("" ::: "memory"); } while (0)
__device__ __forceinline__ int opaque_tid() { int t = threadIdx.x; asm volatile("" : "+v"(t)); return t; }

namespace pg8 {
constexpr int BM = 256, BK = 64, HALF = 128, HTB = HALF * BK * 2, STAGE_BYTES = 8 * HTB, NXCD = 8, WGM = 8;
__host__ __device__ __forceinline__ int lds_byte(int r, int c) { const int st = (r >> 4) * 2 + (c >> 5), rr = r & 15, cc = c & 31, ob = rr * 64 + cc * 2; return st * 1024 + (ob ^ (((ob >> 9) & 1) << 5)); }
__host__ __device__ __forceinline__ void stage_rc(int b, int& R, int& C) { const int st = b / 1024, sb = b % 1024, swz = sb ^ (((sb >> 9) & 1) << 5); R = (st >> 1) * 16 + swz / 64; C = (st & 1) * 32 + (swz % 64) / 2; }
__host__ __device__ __forceinline__ int perm32(int rho) { const int n = rho >> 4, i = rho & 15; return 8 * (i >> 2) + 4 * n + (i & 3); }

struct Unit { int pm, pn; };
struct Gemm { const bf16_t* A; const bf16_t* Bt; int M, N, K, lda; };

struct StaticOrder {
    int nM, nN, nwg, G, c, wgm;
    __device__ void init(int M, int N, int G_, int c_, int wgm_ = WGM) { nM = M / BM; nN = N / BM; nwg = nM * nN; G = G_; c = c_; wgm = wgm_; }
    __device__ bool next(int i, Unit& u) const {
        const long L = (long)i * G + c; if (L >= nwg) return false;
        int wgid = (int)L; { const int q = nwg / NXCD, r = nwg % NXCD, xcd = wgid % NXCD, off = wgid / NXCD; wgid = (xcd < r ? xcd * (q + 1) : r * (q + 1) + (xcd - r) * q) + off; }
        const int nig = wgm * nN, gid = wgid / nig, fm = gid * wgm, gsz = (nM - fm) < wgm ? (nM - fm) : wgm;
        u.pm = fm + ((wgid % nig) % gsz); u.pn = (wgid % nig) / gsz; return true;
    }
};

struct EpiBf16 {
    static constexpr bool PERM = true;
    bf16_t* O; size_t tile_elems;
    __device__ __forceinline__ void operator()(const f32x4 (&acc)[2][2][4][2], const Unit& u, int wr, int wc, int fr, int fq) const {
        const int row0 = u.pm * BM + wr * 64 + fr, col0 = wc * 32 + 8 * fq;
#pragma unroll
        for (int ai = 0; ai < 2; ++ai)
#pragma unroll
            for (int m = 0; m < 4; ++m) { bf16_t* rowp = O + (size_t)u.pn * tile_elems + (size_t)(row0 + ai * HALF + m * 16) * 256 + col0;
#pragma unroll
                for (int bj = 0; bj < 2; ++bj) { const f32x4 v0 = acc[ai][bj][m][0], v1 = acc[ai][bj][m][1];
                    u32x4 w; w.x = cvt_pk_bf16(v0[0], v0[1]); w.y = cvt_pk_bf16(v0[2], v0[3]); w.z = cvt_pk_bf16(v1[0], v1[1]); w.w = cvt_pk_bf16(v1[2], v1[3]);
                    *(u32x4*)(rowp + bj * HALF) = w; } }
    }
};
struct EpiScaleBf16 {
    static constexpr bool PERM = true;
    bf16_t* O; int ldc; float scale;
    __device__ __forceinline__ void operator()(const f32x4 (&acc)[2][2][4][2], const Unit& u, int wr, int wc, int fr, int fq) const {
        const int row0 = u.pm * BM + wr * 64 + fr, col0 = u.pn * BM + wc * 32 + 8 * fq;
#pragma unroll
        for (int ai = 0; ai < 2; ++ai)
#pragma unroll
            for (int m = 0; m < 4; ++m) { bf16_t* rowp = O + (size_t)(row0 + ai * HALF + m * 16) * ldc + col0;
#pragma unroll
                for (int bj = 0; bj < 2; ++bj) { const f32x4 v0 = acc[ai][bj][m][0] * scale, v1 = acc[ai][bj][m][1] * scale;
                    u32x4 w; w.x = cvt_pk_bf16(v0[0], v0[1]); w.y = cvt_pk_bf16(v0[2], v0[3]); w.z = cvt_pk_bf16(v1[0], v1[1]); w.w = cvt_pk_bf16(v1[2], v1[3]);
                    *(u32x4*)(rowp + bj * HALF) = w; } }
    }
};
struct EpiSwiglu {
    static constexpr bool PERM = true;
    bf16_t* O; int ldc;
    __device__ __forceinline__ void operator()(const f32x4 (&acc)[2][2][4][2], const Unit& u, int wr, int wc, int fr, int fq) const {
        const int row0 = u.pm * BM + wr * 64 + fr, col0 = u.pn * HALF + wc * 32 + 8 * fq;
#pragma unroll
        for (int ai = 0; ai < 2; ++ai)
#pragma unroll
            for (int m = 0; m < 4; ++m) { bf16_t* rowp = O + (size_t)(row0 + ai * HALF + m * 16) * ldc + col0;
                float h[8];
#pragma unroll
                for (int n = 0; n < 2; ++n)
#pragma unroll
                    for (int j = 0; j < 4; ++j) h[4 * n + j] = siluf_(acc[ai][0][m][n][j]) * acc[ai][1][m][n][j];
                *(u32x4*)rowp = pack8(h); }
    }
};
struct EpiResF32 {
    static constexpr bool PERM = false;
    const float* res; float* out; int ldc; float alpha, scale;
    __device__ __forceinline__ void operator()(const f32x4 (&acc)[2][2][4][2], const Unit& u, int wr, int wc, int fr, int fq) const {
        const int row0 = u.pm * BM + wr * 64 + fr, col0 = u.pn * BM + wc * 32 + 4 * fq;
#pragma unroll
        for (int ai = 0; ai < 2; ++ai)
#pragma unroll
            for (int m = 0; m < 4; ++m) { const size_t off = (size_t)(row0 + ai * HALF + m * 16) * ldc + col0;
#pragma unroll
                for (int bj = 0; bj < 2; ++bj)
#pragma unroll
                    for (int n = 0; n < 2; ++n) { const size_t o = off + bj * HALF + n * 16; const f32x4 r = *(const f32x4*)(res + o); *(f32x4*)(out + o) = r * alpha + acc[ai][bj][m][n] * scale; } }
    }
};
template <int MODE> struct EpiGate {
    static constexpr bool PERM = true;
    const bf16_t* G; size_t tile_elems; bf16_t* O; int ldo;
    __device__ __forceinline__ void operator()(const f32x4 (&acc)[2][2][4][2], const Unit& u, int wr, int wc, int fr, int fq) const {
        const int row0 = u.pm * BM + wr * 64 + fr, col0 = u.pn * BM + wc * 32 + 8 * fq;
#pragma unroll
        for (int ai = 0; ai < 2; ++ai)
#pragma unroll
            for (int m = 0; m < 4; ++m) { const size_t row = (size_t)(row0 + ai * HALF + m * 16);
#pragma unroll
                for (int bj = 0; bj < 2; ++bj) { const bf16_t* gp = G + (size_t)u.pn * tile_elems + row * 256 + (wc * 32 + 8 * fq) + bj * HALF; bf16_t* op = O + row * ldo + col0 + bj * HALF; float s[8], g[8], o[8];
                    unpack8(*(const u32x4*)gp, g);
                    if (MODE == 1) unpack8(*(const u32x4*)op, s);
#pragma unroll
                    for (int j = 0; j < 8; ++j) { const float a = acc[ai][bj][m][j >> 2][j & 3]; o[j] = (MODE == 0) ? sigmoidf_(g[j]) * a : s[j] + sigmoidf_(g[j]) * a; }
                    *(u32x4*)op = pack8(o); } }
    }
};

template <class Epi>
__device__ __forceinline__ void gemm_phase(LAS unsigned char* lds, const Gemm g, const StaticOrder& S, const Epi& E) {
    const int tid = opaque_tid(), wid = __builtin_amdgcn_readfirstlane(tid >> 6), lane = tid & 63, wr = wid >> 2, wc = wid & 3, fr = lane & 15, fq = lane >> 4;
    const int K = g.K, nt = K / BK, lda = g.lda;
    unsigned voffA[2], voffB[2];
#pragma unroll
    for (int i = 0; i < 2; ++i) { int R, C; stage_rc(tid * 16 + i * 8192, R, C); const int Rb = Epi::PERM ? ((R & ~31) + perm32(R & 31)) : R;
        voffA[i] = (unsigned)(R * lda + C) * 2u; voffB[i] = (unsigned)(Rb * K + C) * 2u; }
    const size_t kstep = (size_t)(BK * 2);
    const size_t hstepA = (size_t)HALF * lda * 2, hstepB = (size_t)HALF * K * 2;
    const size_t tstepA = 2 * hstepA, tstepB = 2 * hstepB;
    const unsigned ldsw = (unsigned)wid * 1024u;
    const int aoff = lds_byte(wr * 64 + fr, fq * 8), boff = lds_byte(wc * 32 + fr, fq * 8);
#define PG8_SA(b, h) (((b) * 2 + (h)) * HTB)
#define PG8_SB(b, h) ((4 + (b) * 2 + (h)) * HTB)
#define PG8_STAGE(bufoff, gbase, voff) do { _Pragma("unroll") for (int _i = 0; _i < 2; ++_i) \
        __builtin_amdgcn_global_load_lds((const unsigned*)((const char*)(gbase) + (voff)[_i]), (LAS unsigned*)(lds + (bufoff) + ldsw + _i * 8192), 16, 0, 0); } while (0)
#define PG8_LDA(dst, b, h) do { _Pragma("unroll") for (int m = 0; m < 4; ++m) _Pragma("unroll") for (int k = 0; k < 2; ++k) dst[m][k] = *(const LAS bf16x8*)(lds + PG8_SA(b, h) + aoff + m * 2048 + k * 1024); } while (0)
#define PG8_LDB(dst, b, h) do { _Pragma("unroll") for (int n = 0; n < 2; ++n) _Pragma("unroll") for (int k = 0; k < 2; ++k) dst[n][k] = *(const LAS bf16x8*)(lds + PG8_SB(b, h) + boff + n * 2048 + k * 1024); } while (0)
#define PG8_MMA(ai, bj, At, Bt) do { __builtin_amdgcn_s_setprio(1); _Pragma("unroll") for (int m = 0; m < 4; ++m) _Pragma("unroll") for (int n = 0; n < 2; ++n) _Pragma("unroll") for (int k = 0; k < 2; ++k) \
        acc[ai][bj][m][n] = __builtin_amdgcn_mfma_f32_16x16x32_bf16(Bt[n][k], At[m][k], acc[ai][bj][m][n], 0, 0, 0); __builtin_amdgcn_s_setprio(0); } while (0)
#define PG8_WAIT_V(n) asm volatile("s_waitcnt vmcnt(" #n ")" ::: "memory")
#define PG8_WAIT_L(n) asm volatile("s_waitcnt lgkmcnt(" #n ")" ::: "memory")
#define PG8_BAR __builtin_amdgcn_s_barrier()
#define PG8_SCHED __builtin_amdgcn_sched_barrier(0)
    Unit cur, nxt; int ui = 0;
    if (!S.next(0, cur)) return;
    f32x4 acc[2][2][4][2];
#pragma unroll
    for (int a = 0; a < 2; ++a)
#pragma unroll
        for (int b = 0; b < 2; ++b)
#pragma unroll
            for (int m = 0; m < 4; ++m)
#pragma unroll
                for (int n = 0; n < 2; ++n) acc[a][b][m][n] = (f32x4){0.f, 0.f, 0.f, 0.f};
    bf16x8 At[4][2], B0[2][2], B1[2][2];
    const char* cA = (const char*)g.A + (size_t)cur.pm * tstepA; const char* cB = (const char*)g.Bt + (size_t)cur.pn * tstepB;
    PG8_STAGE(PG8_SB(0, 0), cB, voffB); PG8_STAGE(PG8_SB(0, 1), cB + hstepB, voffB); PG8_STAGE(PG8_SA(0, 0), cA, voffA); PG8_STAGE(PG8_SA(0, 1), cA + hstepA, voffA);
    if (wr == 1) PG8_BAR;
    PG8_WAIT_V(2); PG8_BAR;
    PG8_STAGE(PG8_SB(1, 0), cB + kstep, voffB); PG8_STAGE(PG8_SA(1, 0), cA + kstep, voffA); PG8_STAGE(PG8_SB(1, 1), cB + hstepB + kstep, voffB);
    PG8_WAIT_V(6); PG8_BAR;
    for (;;) {
        const bool has_next = S.next(ui + 1, nxt);
        const char* nA = has_next ? (const char*)g.A + (size_t)nxt.pm * tstepA : cA; const char* nB = has_next ? (const char*)g.Bt + (size_t)nxt.pn * tstepB : cB;
        for (int t = 0; t < nt; t += 2) {
            const bool last = (t == nt - 2);
            const char* a1 = cA + (size_t)(t + 1) * kstep;
            const char* a2 = last ? nA : cA + (size_t)(t + 2) * kstep; const char* b2 = last ? nB : cB + (size_t)(t + 2) * kstep;
            const char* a3 = a2 + kstep; const char* b3 = b2 + kstep;
            PG8_LDB(B0, 0, 0); PG8_LDB(B1, 0, 1); PG8_SCHED; PG8_LDA(At, 0, 0); PG8_STAGE(PG8_SA(1, 1), a1 + hstepA, voffA);
            PG8_WAIT_V(8); PG8_WAIT_L(0); PG8_BAR; PG8_MMA(0, 0, At, B0); PG8_MMA(0, 1, At, B1); PG8_BAR; PG8_SCHED;
            PG8_LDA(At, 0, 1); PG8_STAGE(PG8_SB(0, 0), b2, voffB); PG8_STAGE(PG8_SB(0, 1), b2 + hstepB, voffB); PG8_STAGE(PG8_SA(0, 0), a2, voffA);
            PG8_WAIT_V(8); PG8_WAIT_L(0); PG8_BAR; PG8_MMA(1, 0, At, B0); PG8_MMA(1, 1, At, B1); PG8_BAR; PG8_SCHED;
            PG8_LDB(B0, 1, 0); PG8_LDB(B1, 1, 1); PG8_SCHED; PG8_LDA(At, 1, 0); PG8_STAGE(PG8_SA(0, 1), a2 + hstepA, voffA);
            PG8_WAIT_V(8); PG8_WAIT_L(0); PG8_BAR; PG8_MMA(0, 0, At, B0); PG8_MMA(0, 1, At, B1); PG8_BAR; PG8_SCHED;
            PG8_LDA(At, 1, 1); PG8_STAGE(PG8_SB(1, 0), b3, voffB); PG8_STAGE(PG8_SB(1, 1), b3 + hstepB, voffB); PG8_STAGE(PG8_SA(1, 0), a3, voffA);
            PG8_WAIT_V(8); PG8_WAIT_L(0); PG8_BAR; PG8_MMA(1, 0, At, B0); PG8_MMA(1, 1, At, B1); PG8_BAR; PG8_SCHED;
        }
        if (wr == 0) PG8_BAR;
        E(acc, cur, wr, wc, fr, fq);
        if (!has_next) break;
#pragma unroll
        for (int a = 0; a < 2; ++a)
#pragma unroll
            for (int b = 0; b < 2; ++b)
#pragma unroll
                for (int m = 0; m < 4; ++m)
#pragma unroll
                    for (int n = 0; n < 2; ++n) acc[a][b][m][n] = (f32x4){0.f, 0.f, 0.f, 0.f};
        cur = nxt; cA = nA; cB = nB; ++ui;
        if (wr == 1) PG8_BAR;
    }
    PG8_WAIT_V(0);
    PG8_BAR;
#undef PG8_SA
#undef PG8_SB
#undef PG8_STAGE
#undef PG8_LDA
#undef PG8_LDB
#undef PG8_MMA
#undef PG8_WAIT_V
#undef PG8_WAIT_L
#undef PG8_BAR
#undef PG8_SCHED
}
}

__device__ __forceinline__ void transpose_item(const float* W, int K, int N, bf16_t* WT, LAS float* scr, int item, int lane, int mode) {
    const int nblk = N / 32, kb = item / nblk, nb = item % nblk, k0 = 64 * kb, n0 = 32 * nb;
    int drow0 = n0;
    if (mode == 1) { if (n0 < DFF) drow0 = 256 * (n0 / 128) + (n0 % 128); else { const int n1 = n0 - DFF; drow0 = 256 * (n1 / 128) + 128 + (n1 % 128); } }
#pragma unroll 8
    for (int i = 0; i < 32; ++i) { const int kk = 2 * i + (lane >> 5); scr[kk * 33 + (lane & 31)] = W[(size_t)(k0 + kk) * N + n0 + (lane & 31)]; }
    LDS_WAIT();
    const int c = lane & 7;
#pragma unroll
    for (int j = 0; j < 4; ++j) { const int n = (lane >> 3) + 8 * j; const LAS float* s = scr + (8 * c) * 33 + n;
        u32x4 o; o.x = cvt_pk_bf16(s[0 * 33], s[1 * 33]); o.y = cvt_pk_bf16(s[2 * 33], s[3 * 33]); o.z = cvt_pk_bf16(s[4 * 33], s[5 * 33]); o.w = cvt_pk_bf16(s[6 * 33], s[7 * 33]);
        *(u32x4*)(WT + (size_t)(drow0 + n) * K + k0 + 8 * c) = o; }
    LDS_WAIT();
}

template <bool HB> struct LnIn { };
template <> struct LnIn<false> { f32x4 x[8]; };
template <> struct LnIn<true> { u32x2 x[8]; };
template <bool HB> __device__ __forceinline__ void ln_load(const void* hin, const bf16_t* z, int m, int mm, int lane, LnIn<HB>& r, u32x2 (&zz)[8]) {
    const u32x2* zr = (const u32x2*)(z + (size_t)mm * DM) + lane;
    if constexpr (HB) { const u32x2* xr = (const u32x2*)((const bf16_t*)hin + (size_t)m * DM) + lane;
#pragma unroll
        for (int j = 0; j < 8; ++j) { r.x[j] = xr[64 * j]; zz[j] = zr[64 * j]; } }
    else { const f32x4* xr = (const f32x4*)((const float*)hin + (size_t)m * DM) + lane;
#pragma unroll
        for (int j = 0; j < 8; ++j) { r.x[j] = xr[64 * j]; zz[j] = zr[64 * j]; } }
}
template <bool HB> __device__ __forceinline__ void ln_finish(const LnIn<HB>& r, const u32x2 (&zz)[8], float* outf, bf16_t* outb, const float* g, const float* b, int m, int lane) {
    f32x4 v[8]; float s = 0.f;
#pragma unroll
    for (int j = 0; j < 8; ++j) { f32x4 x;
        if constexpr (HB) x = (f32x4){bf_lo(r.x[j].x), bf_hi(r.x[j].x), bf_lo(r.x[j].y), bf_hi(r.x[j].y)}; else x = r.x[j];
        v[j] = x * DN_ALPHA + (f32x4){bf_lo(zz[j].x), bf_hi(zz[j].x), bf_lo(zz[j].y), bf_hi(zz[j].y)}; s += (v[j].x + v[j].y) + (v[j].z + v[j].w); }
    const float mean = wave_sum(s) * (1.f / DM); float s2 = 0.f;
#pragma unroll
    for (int j = 0; j < 8; ++j) { v[j] = v[j] - mean; s2 += (v[j].x * v[j].x + v[j].y * v[j].y) + (v[j].z * v[j].z + v[j].w * v[j].w); }
    const float rstd = 1.0f / sqrtf(wave_sum(s2) * (1.f / DM) + LN_EPS);
#pragma unroll
    for (int j = 0; j < 8; ++j) { const f32x4 gv = ((const f32x4*)g)[lane + 64 * j], bv = ((const f32x4*)b)[lane + 64 * j];
        const f32x4 o = v[j] * rstd * gv + bv;
        if (outf) ((f32x4*)(outf + (size_t)m * DM) + lane)[64 * j] = o;
        if (outb) { u32x2 w; w.x = cvt_pk_bf16(o.x, o.y); w.y = cvt_pk_bf16(o.z, o.w); *((u32x2*)(outb + (size_t)m * DM) + lane + 64 * j) = w; } }
}
template <bool HB> __device__ __forceinline__ void ln_rows(const void* hin, const bf16_t* z, float* outf, bf16_t* outb, const float* g, const float* b, int row0, int nrows) {
    const int tid = opaque_tid(), lane = tid & 63, gw = blockIdx.x * 8 + (tid >> 6), ngw = gridDim.x * 8;
    LnIn<HB> xa, xb; u32x2 za[8], zb[8];
    int mm = gw;
    if (mm < nrows) ln_load<HB>(hin, z, row0 + mm, mm, lane, xa, za);
    while (mm < nrows) {
        const int m1 = mm + ngw, m2 = m1 + ngw;
        if (m1 < nrows) ln_load<HB>(hin, z, row0 + m1, m1, lane, xb, zb);
        ln_finish<HB>(xa, za, outf, outb, g, b, row0 + mm, lane);
        if (m1 >= nrows) break;
        if (m2 < nrows) ln_load<HB>(hin, z, row0 + m2, m2, lane, xa, za);
        ln_finish<HB>(xb, zb, outf, outb, g, b, row0 + m1, lane);
        mm = m2;
    }
}

constexpr int HG_BUF = 38656, HG_QD = 0, HG_KD = 8832, HG_VT = 17664, HG_KET = 27904, HG_DEC = 38144, HG_ST = 2 * HG_BUF, HG_END = HG_ST + 34816;
__device__ __forceinline__ int hg_row(int r) { return r * 136 + (r >> 3) * 16; }
static_assert(HG_END <= LDS_BYTES, "hgrn lds");
typedef short bf16x4 __attribute__((ext_vector_type(4)));
__device__ __forceinline__ void hgrn_step(LAS unsigned char* lds, const bf16_t* __restrict__ uq, const bf16_t* __restrict__ ufi, bf16_t* __restrict__ ufo, const bf16_t* __restrict__ uv, unsigned voff, unsigned soff, int n, int dir, int wid, int fr, int fq, int d, float lb,
                                          bf16_t (&rq)[8], bf16_t (&rf)[8], bf16_t (&rv)[8], f32x4 (&sacc)[8]) {
    LAS bf16_t* ST = (LAS bf16_t*)(lds + HG_ST);
    {
        LAS unsigned char* B = lds + (n & 1) * HG_BUF;
        LAS bf16_t* QD = (LAS bf16_t*)(B + HG_QD); LAS bf16_t* KD = (LAS bf16_t*)(B + HG_KD); LAS bf16_t* VT = (LAS bf16_t*)(B + HG_VT); LAS bf16_t* KET = (LAS bf16_t*)(B + HG_KET);
        LAS float* DEC = (LAS float*)(B + HG_DEC);
        float q[8], k[8], v[8], cum[8]; float run = 0.f;
#pragma unroll
        for (int i = 0; i < 8; ++i) { q[i] = siluf_(bf2f(rq[i])); const float f = lb + (1.0f - lb) * sigmoidf_(bf2f(rf[i])); k[i] = 1.0f - f; run += __builtin_amdgcn_logf(f); cum[i] = run;     v[i] = bf2f(rv[i]); }
        {
            const int np = (n + 2 < SEQ / 32) ? (n + 2) : (SEQ / 32 - 1);
#pragma unroll
            for (int i = 0; i < 8; ++i) { const int ut = dir ? (SEQ - 1 - 24 - 32 * np - i) : (32 * np + i);
                const size_t ro = (size_t)ut * 256; rq[i] = (uq + ro)[voff]; rf[i] = (ufi + ro)[voff]; rv[i] = (uv + ro)[voff]; } }
        const float T0 = __shfl(run, fr), T1 = __shfl(run, 16 + fr), T2 = __shfl(run, 32 + fr), T3 = __shfl(run, 48 + fr);
        const float pre = (fq > 0 ? T0 : 0.f) + (fq > 1 ? T1 : 0.f) + (fq > 2 ? T2 : 0.f), tot = (T0 + T1) + (T2 + T3);
        float ke[8];
#pragma unroll
        for (int i = 0; i < 8; ++i) { const float c = cum[i] + pre; QD[hg_row(8 * fq + i) + d] = f2bf(q[i] * __builtin_amdgcn_exp2f(c)); KD[hg_row(8 * fq + i) + d] = f2bf(k[i] * __builtin_amdgcn_exp2f(-c)); ke[i] = k[i] * __builtin_amdgcn_exp2f(tot - c); }
        *(LAS u32x4*)(VT + d * 40 + 8 * fq) = pack8(v); *(LAS u32x4*)(KET + d * 40 + 8 * fq) = pack8(ke);
        if (fq == 0) DEC[d] = __builtin_amdgcn_exp2f(tot);
        BAR_LDS();
        const bf16x8 vB = *(const LAS bf16x8*)(VT + (16 * wid + fr) * 40 + 8 * fq);
        const bf16x4 vlo = *(const LAS bf16x4*)(VT + (16 * wid + fr) * 40 + 4 * fq), vhi = *(const LAS bf16x4*)(VT + (16 * wid + fr) * 40 + 16 + 4 * fq);
        const bf16x8 vBp = __builtin_shufflevector(vlo, vhi, 0, 1, 2, 3, 4, 5, 6, 7);
#pragma unroll
        for (int ct = 0; ct < 2; ++ct) {
            bf16x8 qf[4];
#pragma unroll
            for (int kk = 0; kk < 4; ++kk) qf[kk] = *(const LAS bf16x8*)(QD + hg_row(16 * ct + fr) + 32 * kk + 8 * fq);
            f32x4 at0 = (f32x4){0.f, 0.f, 0.f, 0.f}, at1 = (f32x4){0.f, 0.f, 0.f, 0.f};
#pragma unroll
            for (int kk = 0; kk < 4; ++kk) { const bf16x8 kf = *(const LAS bf16x8*)(KD + hg_row(fr) + 32 * kk + 8 * fq); at0 = __builtin_amdgcn_mfma_f32_16x16x32_bf16(kf, qf[kk], at0, 0, 0, 0); }
            if (ct == 1) {
#pragma unroll
                for (int kk = 0; kk < 4; ++kk) { const bf16x8 kf = *(const LAS bf16x8*)(KD + hg_row(16 + fr) + 32 * kk + 8 * fq); at1 = __builtin_amdgcn_mfma_f32_16x16x32_bf16(kf, qf[kk], at1, 0, 0, 0); } }
            const int cc = 16 * ct + fr;
#pragma unroll
            for (int r = 0; r < 4; ++r) { at0[r] = (4 * fq + r <= cc) ? at0[r] : 0.f; at1[r] = (ct == 1 && 16 + 4 * fq + r <= cc) ? at1[r] : 0.f; }
            u32x4 aw; aw.x = cvt_pk_bf16(at0[0], at0[1]); aw.y = cvt_pk_bf16(at0[2], at0[3]); aw.z = cvt_pk_bf16(at1[0], at1[1]); aw.w = cvt_pk_bf16(at1[2], at1[3]);
            const bf16x8 af = __builtin_bit_cast(bf16x8, aw);
            f32x4 o = (f32x4){0.f, 0.f, 0.f, 0.f};
#pragma unroll
            for (int kk = 0; kk < 4; ++kk) { const bf16x8 sf = *(const LAS bf16x8*)(ST + (16 * wid + fr) * 136 + 32 * kk + 8 * fq); o = __builtin_amdgcn_mfma_f32_16x16x32_bf16(qf[kk], sf, o, 0, 0, 0); }
            o = __builtin_amdgcn_mfma_f32_16x16x32_bf16(af, vBp, o, 0, 0, 0);
#pragma unroll
            for (int r = 0; r < 4; ++r) { const int ut = dir ? (SEQ - 1 - 12 - 32 * n - 16 * ct - r) : (32 * n + 16 * ct + r);
                (ufo + (size_t)ut * 256)[soff] = f2bf(o[r]); }
        }
#pragma unroll
        for (int i = 0; i < 8; ++i) { const f32x4 dec = *(const LAS f32x4*)(DEC + 16 * i + 4 * fq);
            const bf16x8 a = *(const LAS bf16x8*)(KET + (16 * i + fr) * 40 + 8 * fq);
            sacc[i] = __builtin_amdgcn_mfma_f32_16x16x32_bf16(a, vB, sacc[i] * dec, 0, 0, 0);
            u32x2 w; w.x = cvt_pk_bf16(sacc[i][0], sacc[i][1]); w.y = cvt_pk_bf16(sacc[i][2], sacc[i][3]);
            *(LAS u32x2*)(ST + (16 * wid + fr) * 136 + 16 * i + 4 * fq) = w; }
    }
}
__device__ __forceinline__ void hgrn_item(LAS unsigned char* lds, bf16_t* proj, const float* lbvec  , int item) {
    const int tid = opaque_tid(), lane = tid & 63, wid = __builtin_amdgcn_readfirstlane(tid >> 6);
    const int slot = (item & 255) >> 3, pair = (slot >> 1) + 16 * (item & 7) + 128 * (item >> 8);
    const int dir = slot & 1, h = pair & 15, bl = pair >> 4;
    const int fr = lane & 15, fq = lane >> 4, d = 16 * wid + fr;
    const int fcol = dir ? C_HFB : C_HFF;
    const float lb = lbvec[dir * DM + h * 128 + d];
    LAS bf16_t* ST = (LAS bf16_t*)(lds + HG_ST);
    for (int i = tid; i < 34816 / 4; i += 512) ((LAS unsigned*)ST)[i] = 0u;
    f32x4 sacc[8];
#pragma unroll
    for (int i = 0; i < 8; ++i) sacc[i] = (f32x4){0.f, 0.f, 0.f, 0.f};
    const size_t rowbase = (size_t)bl * SEQ;
    const bf16_t* uq = proj + pcol(C_HQ + h * 128) - (size_t)(h & 1) * 128 + rowbase * 256; bf16_t* uf = proj + pcol(fcol + h * 128) - (size_t)(h & 1) * 128 + rowbase * 256; const bf16_t* uv = proj + pcol(C_HI + h * 128) - (size_t)(h & 1) * 128 + rowbase * 256;
    const unsigned colw = (unsigned)((h & 1) * 128 + d);
    const unsigned voff = (unsigned)(dir ? (24 - 8 * fq) : 8 * fq) * 256u + colw;
    const unsigned soff = (unsigned)(dir ? (12 - 4 * fq) : 4 * fq) * 256u + colw;
    bf16_t rq[8], rf[8], rv[8], rq1[8], rf1[8], rv1[8];
#pragma unroll
    for (int i = 0; i < 8; ++i) { const int ut = dir ? (SEQ - 1 - 24 - i) : i; const size_t ro = (size_t)ut * 256; rq[i] = (uq + ro)[voff]; rf[i] = (uf + ro)[voff]; rv[i] = (uv + ro)[voff]; }
#pragma unroll
    for (int i = 0; i < 8; ++i) { const int ut = dir ? (SEQ - 1 - 24 - 32 - i) : (32 + i); const size_t ro = (size_t)ut * 256; rq1[i] = (uq + ro)[voff]; rf1[i] = (uf + ro)[voff]; rv1[i] = (uv + ro)[voff]; }
    BAR_LDS();
    for (int n = 0; n < SEQ / 32; n += 2) {
        hgrn_step(lds, uq, uf, uf, uv, voff, soff, n, dir, wid, fr, fq, d, lb, rq, rf, rv, sacc);
        hgrn_step(lds, uq, uf, uf, uv, voff, soff, n + 1, dir, wid, fr, fq, d, lb, rq1, rf1, rv1, sacc);
    }
    BAR_LDS();
}

constexpr int AT_QS = 0, AT_KS = 17408, AT_VT = AT_KS + 52224, AT_PS = AT_VT + 53248, AT_END = AT_PS + 4 * 5376;
static_assert(AT_END <= LDS_BYTES - 16, "attn lds");
struct AttnUnit { int g, hh, dl, seg, r, n, qcol; size_t rowbase; };
__device__ __forceinline__ AttnUnit attn_decode(int i) {
    const int u = (((i >> 8) * 8 + (i & 7)) << 5) + ((i & 255) >> 3);
    AttnUnit A; const int qb = u & 31; A.hh = (u >> 5) & 3; const int bl = (u >> 7) & 7; A.g = u >> 10;
    const int sh = 2 * A.g, nblk = 32 >> sh; A.dl = 1 << sh; A.seg = SEQ >> sh; A.r = qb / nblk; A.n = qb % nblk;
    A.qcol = C_QKV + A.g * 1536 + A.hh * 128; A.rowbase = (size_t)bl * SEQ; return A;
}
__device__ __forceinline__ void attn_load(const bf16_t* proj, const float* rope, const AttnUnit& A, int tid, u32x4 (&qr)[2], u32x4 (&kr)[6], u32x4 (&vr)[6], float (&cs)[8], float (&sn)[8]) {
#pragma unroll
    for (int it = 0; it < 2; ++it) { const int ci = tid + 512 * it, row = ci >> 4, ch = ci & 15; const int pos = (64 * A.n + row) * A.dl + A.r;
        qr[it] = *(const u32x4*)(proj + pcol(A.qcol) + (A.rowbase + pos) * 256 + 8 * ch); }
#pragma unroll
    for (int it = 0; it < 6; ++it) { const int ci = tid + 512 * it, ch = ci / 192, row = ci - 192 * ch; const int kj = 64 * A.n - 64 + row; const bool ok = (kj >= 0) && (kj < A.seg);
        const int pos = ok ? kj * A.dl + A.r : 0; const size_t ro = (A.rowbase + pos) * 256 + 8 * ch;
        kr[it] = *(const u32x4*)(proj + pcol(A.qcol + 512) + ro); vr[it] = *(const u32x4*)(proj + pcol(A.qcol + 1024) + ro); }
#pragma unroll
    for (int it = 0; it < 8; ++it) { const int idx = tid + 512 * it, row = idx >> 4, i = idx & 15; int pos;
        if (row < 64) pos = (64 * A.n + row) * A.dl + A.r; else { const int kj = 64 * A.n - 64 + (row - 64); pos = ((kj >= 0) && (kj < A.seg)) ? kj * A.dl + A.r : 0; }
        cs[it] = rope[pos * 32 + i]; sn[it] = rope[pos * 32 + 16 + i]; }
}
__device__ __forceinline__ void attn_phase(LAS unsigned char* lds, bf16_t* proj, float* lse, const float* rope, int u0, int ustride, int nunits) {
    const int tid = opaque_tid(), lane = tid & 63, wid = __builtin_amdgcn_readfirstlane(tid >> 6);
    LAS bf16_t* QS = (LAS bf16_t*)(lds + AT_QS); LAS bf16_t* KS = (LAS bf16_t*)(lds + AT_KS); LAS bf16_t* VT = (LAS bf16_t*)(lds + AT_VT);
    for (int i = tid; i < 128 * 16; i += 512) { const int rw = i >> 4, cc = i & 15; VT[rw * 208 + 192 + cc] = 0; }
    if (u0 >= nunits) { BAR_LDS(); return; }
    u32x4 qr[2], kr[6], vr[6]; float rcs[8], rsn[8];
    AttnUnit A = attn_decode(u0);
    attn_load(proj, rope, A, tid, qr, kr, vr, rcs, rsn);
    for (int u = u0; u < nunits; u += ustride) {
        const int n = A.n, dl = A.dl, r = A.r, seg = A.seg, hh = A.hh, g = A.g, qcol = A.qcol; const size_t rowbase = A.rowbase;
#pragma unroll
        for (int it = 0; it < 2; ++it) { const int ci = tid + 512 * it, row = ci >> 4, ch = ci & 15; *(LAS u32x4*)(QS + row * 136 + 8 * ch) = qr[it]; }
#pragma unroll
        for (int it = 0; it < 6; ++it) { const int ci = tid + 512 * it, ch = ci / 192, row = ci - 192 * ch; const int kj = 64 * n - 64 + row; const bool ok = (kj >= 0) && (kj < seg);
            u32x4 kv = kr[it], vv = vr[it];
            if (!ok) { kv = (u32x4){0u, 0u, 0u, 0u}; vv = (u32x4){0u, 0u, 0u, 0u}; }
            *(LAS u32x4*)(KS + row * 136 + 8 * ch) = kv;
            LAS bf16_t* vt = VT + (8 * ch) * 208 + row;
            vt[0 * 208] = (bf16_t)(vv.x & 0xffffu); vt[1 * 208] = (bf16_t)(vv.x >> 16); vt[2 * 208] = (bf16_t)(vv.y & 0xffffu); vt[3 * 208] = (bf16_t)(vv.y >> 16);
            vt[4 * 208] = (bf16_t)(vv.z & 0xffffu); vt[5 * 208] = (bf16_t)(vv.z >> 16); vt[6 * 208] = (bf16_t)(vv.w & 0xffffu); vt[7 * 208] = (bf16_t)(vv.w >> 16); }
        float cs[8], sn[8];
#pragma unroll
        for (int it = 0; it < 8; ++it) { cs[it] = rcs[it]; sn[it] = rsn[it]; }
        BAR_LDS();
        if (u + ustride < nunits) { A = attn_decode(u + ustride); attn_load(proj, rope, A, tid, qr, kr, vr, rcs, rsn); }
#pragma unroll
        for (int it = 0; it < 8; ++it) { const int idx = tid + 512 * it, row = idx >> 4, i = idx & 15;
            int pos; LAS bf16_t* p; bool ok = true;
            if (row < 64) { pos = (64 * n + row) * dl + r; p = QS + row * 136; }
            else { const int kj = 64 * n - 64 + (row - 64); ok = (kj >= 0) && (kj < seg); pos = ok ? kj * dl + r : 0; p = KS + (row - 64) * 136; }
            const float x1 = bf2f(p[i]), x2 = bf2f(p[16 + i]);
            if (ok) { p[i] = f2bf(x1 * cs[it] - x2 * sn[it]); p[16 + i] = f2bf(x2 * cs[it] + x1 * sn[it]); } }
        BAR_LDS();
        if (wid < 4) {
            const int w = wid, fr = lane & 15, fq = lane >> 4;
            LAS bf16_t* PS = (LAS bf16_t*)(lds + AT_PS + w * 5376);
            bf16x8 aq[4];
#pragma unroll
            for (int kk = 0; kk < 4; ++kk) aq[kk] = *(const LAS bf16x8*)(QS + (16 * w + fr) * 136 + 32 * kk + 8 * fq);
            f32x4 sc[9];
#pragma unroll
            for (int t = 0; t < 9; ++t) { sc[t] = (f32x4){0.f, 0.f, 0.f, 0.f};
#pragma unroll
                for (int kk = 0; kk < 4; ++kk) { const bf16x8 b = *(const LAS bf16x8*)(KS + (16 * (w + t) + fr) * 136 + 32 * kk + 8 * fq);
                    sc[t] = __builtin_amdgcn_mfma_f32_16x16x32_bf16(aq[kk], b, sc[t], 0, 0, 0); } }
            float mx[4] = {-3.0e38f, -3.0e38f, -3.0e38f, -3.0e38f};
#pragma unroll
            for (int t = 0; t < 9; ++t)
#pragma unroll
                for (int rr = 0; rr < 4; ++rr) { const int ql = 16 * w + 4 * fq + rr, jj = 16 * (w + t) + fr; const int kj = 64 * n - 64 + jj; const int dd = ql + 64 - jj;
                    const bool ok = (dd <= 64) && (dd >= -64) && (kj >= 0) && (kj < seg);
                    const float val = ok ? sc[t][rr] * 0.08838834764831845f : -1.0e30f; sc[t][rr] = val; mx[rr] = fmaxf(mx[rr], val); }
#pragma unroll
            for (int rr = 0; rr < 4; ++rr) {
#pragma unroll
                for (int o = 1; o < 16; o <<= 1) mx[rr] = fmaxf(mx[rr], __shfl_xor(mx[rr], o)); }
            float sm[4] = {0.f, 0.f, 0.f, 0.f};
#pragma unroll
            for (int t = 0; t < 9; ++t)
#pragma unroll
                for (int rr = 0; rr < 4; ++rr) { const float p = __expf(sc[t][rr] - mx[rr]); sm[rr] += p; PS[(4 * fq + rr) * 168 + 16 * t + fr] = f2bf(p); }
#pragma unroll
            for (int rr = 0; rr < 4; ++rr) { PS[(4 * fq + rr) * 168 + 144 + fr] = 0;
#pragma unroll
                for (int o = 1; o < 16; o <<= 1) sm[rr] += __shfl_xor(sm[rr], o); }
            LDS_WAIT();
            f32x4 oacc[8];
#pragma unroll
            for (int nt = 0; nt < 8; ++nt) oacc[nt] = (f32x4){0.f, 0.f, 0.f, 0.f};
#pragma unroll
            for (int kk = 0; kk < 5; ++kk) { const bf16x8 a = *(const LAS bf16x8*)(PS + fr * 168 + 32 * kk + 8 * fq);
#pragma unroll
                for (int nt = 0; nt < 8; ++nt) { const bf16x8 b = *(const LAS bf16x8*)(VT + (16 * nt + fr) * 208 + 16 * w + 32 * kk + 8 * fq);
                    oacc[nt] = __builtin_amdgcn_mfma_f32_16x16x32_bf16(a, b, oacc[nt], 0, 0, 0); } }
#pragma unroll
            for (int rr = 0; rr < 4; ++rr) { const int ql = 16 * w + 4 * fq + rr; const int pos = (64 * n + ql) * dl + r; const float inv = 1.0f / sm[rr];
                bf16_t* orow = proj + pcol(qcol) + (rowbase + pos) * 256;
#pragma unroll
                for (int nt = 0; nt < 8; ++nt) orow[16 * nt + fr] = f2bf(oacc[nt][rr] * inv);
                if (fr == 0) lse[((size_t)g * MH + rowbase + pos) * 4 + hh] = mx[rr] + __logf(sm[rr]); }
        }
        BAR_LDS();
    }
}

__device__ __forceinline__ void mixer_finalize(bf16_t* proj, const float* lse, const float* normg, bf16_t* ohg, bf16_t* attnc) {
    const int tid = opaque_tid(), lane = tid & 63, gw = blockIdx.x * 8 + (tid >> 6), ngw = gridDim.x * 8;
    for (int m = gw; m < MH; m += ngw) {
        const bf16_t* row = proj + (size_t)m * 256;
        float o[32]; float ss = 0.f;
#pragma unroll
        for (int j = 0; j < 4; ++j) { float a[8], b[8]; unpack8(*(const u32x4*)(row + pcol(C_HFF + 32 * lane + 8 * j)), a); unpack8(*(const u32x4*)(row + pcol(C_HFB + 32 * lane + 8 * j)), b);
#pragma unroll
            for (int k = 0; k < 8; ++k) { const float x = a[k] + b[k]; o[8 * j + k] = x; ss += x * x; } }
        ss += __shfl_xor(ss, 1); ss += __shfl_xor(ss, 2);
        const float rs = 1.0f / sqrtf(ss * (1.f / 128.f) + LN_EPS);
#pragma unroll
        for (int j = 0; j < 4; ++j) { float og[8], res[8]; unpack8(*(const u32x4*)(row + pcol(C_HOG + 32 * lane + 8 * j)), og);
            const f32x4 g0 = *(const f32x4*)(normg + 32 * lane + 8 * j), g1 = *(const f32x4*)(normg + 32 * lane + 8 * j + 4);
#pragma unroll
            for (int k = 0; k < 8; ++k) res[k] = o[8 * j + k] * rs * (k < 4 ? g0[k] : g1[k - 4]) * siluf_(og[k]);
            *(u32x4*)(ohg + (size_t)m * DM + 32 * lane + 8 * j) = pack8(res); }
        const int hh = lane >> 4, d = 8 * (lane & 15);
        const float l0 = lse[((size_t)0 * MH + m) * 4 + hh], l1 = lse[((size_t)1 * MH + m) * 4 + hh], l2 = lse[((size_t)2 * MH + m) * 4 + hh];
        const float mxl = fmaxf(l0, fmaxf(l1, l2)); float w0 = __expf(l0 - mxl), w1 = __expf(l1 - mxl), w2 = __expf(l2 - mxl); const float iw = 1.0f / (w0 + w1 + w2); w0 *= iw; w1 *= iw; w2 *= iw;
        float a0[8], a1[8], a2[8], res[8];
        unpack8(*(const u32x4*)(row + pcol(C_QKV + 0 * 1536 + hh * 128 + d)), a0); unpack8(*(const u32x4*)(row + pcol(C_QKV + 1 * 1536 + hh * 128 + d)), a1); unpack8(*(const u32x4*)(row + pcol(C_QKV + 2 * 1536 + hh * 128 + d)), a2);
#pragma unroll
        for (int k = 0; k < 8; ++k) res[k] = w0 * a0[k] + w1 * a1[k] + w2 * a2[k];
        *(u32x4*)(attnc + (size_t)m * 512 + hh * 128 + d) = pack8(res);
    }
}

#ifndef PROBE_MASK
#define PROBE_MASK 0
#endif
#ifndef PROBE_MODE
#define PROBE_MODE 0
#endif
#define PB_GEMM_FFN 1
#define PB_GEMM_MIX 2
#define PB_HGRN 4
#define PB_ATTN 8
#define PB_FIN 16
#define PB_LN 32
#define PB_PRO 64
#define PB_BAR 128
#define TIC() do { if (PROBE_MASK) { __builtin_amdgcn_s_barrier(); pb_t0 = __builtin_amdgcn_s_memrealtime(); } } while (0)
#define TOC(bit) do { if (PROBE_MASK & (bit)) { __builtin_amdgcn_s_barrier(); pb_acc += __builtin_amdgcn_s_memrealtime() - pb_t0; } } while (0)
#define XB_TMO      128
#define XB_XCNT(j)  (256  + 64 * (j))
#define XB_XSUB(j)  (1280 + 64 * (j))
#define XB_XGEN(j)  (2304 + 64 * (j))
#define XB_TOP      3328
#define XB_TOPGEN   3392
#define XCD_BAR_WORDS 3456
#define XB_SPIN_CAP (1u << 18)
__device__ __forceinline__ unsigned xb_ld(unsigned* p)              { return __hip_atomic_load(p, __ATOMIC_RELAXED, __HIP_MEMORY_SCOPE_AGENT); }
__device__ __forceinline__ unsigned xb_add(unsigned* p, unsigned v) { return __hip_atomic_fetch_add(p, v, __ATOMIC_RELAXED, __HIP_MEMORY_SCOPE_AGENT); }
__device__ __forceinline__ unsigned xb_xcc_id() { return (unsigned)__builtin_amdgcn_s_getreg((3 << 11) | 20) & 0xFu; }
#define XB_SPIN(cond, bar) do { unsigned _sp = 0; while (cond) { __builtin_amdgcn_s_sleep(1); \
    if ((++_sp & 255u) == 0u) { if (xb_ld(&(bar)[XB_TMO])) break; if (_sp > XB_SPIN_CAP) { atomicAdd(&(bar)[XB_TMO], 1u); break; } } } } while (0)
struct XcdBarrier { unsigned* bar; unsigned x; volatile LAS unsigned* st; };
__device__ __forceinline__ XcdBarrier xcd_barrier_post(unsigned* bar, volatile LAS unsigned* st) {
    XcdBarrier b; b.bar = bar; b.x = xb_xcc_id(); b.st = st;
    if (threadIdx.x == 0) (void)xb_add(&bar[XB_XCNT(b.x)], 1u);
    return b;
}
__device__ __forceinline__ void xcd_barrier_complete(unsigned* bar, unsigned x, unsigned& nloc, unsigned& nx) {
    const unsigned G = gridDim.x * gridDim.y * gridDim.z;
    unsigned sum, cnt, mine, sp = 0u;
    for (;;) {
        sum = 0u; cnt = 0u; mine = 0u;
#pragma unroll
        for (unsigned j = 0; j < 16; ++j) { const unsigned c = xb_ld(&bar[XB_XCNT(j)]); sum += c; cnt += (c > 0u) ? 1u : 0u; mine = (j == x) ? c : mine; }
        if (sum == G) break;
        __builtin_amdgcn_s_sleep(1);
        if ((++sp & 255u) == 0u) { if (xb_ld(&bar[XB_TMO])) break; if (sp > XB_SPIN_CAP) { atomicAdd(&bar[XB_TMO], 1u); break; } }
    }
    nloc = mine > 0u ? mine : 1u; nx = cnt > 0u ? cnt : 1u;
}
__device__ __forceinline__ void xcd_barrier(const XcdBarrier& b) {
    asm volatile("s_waitcnt vmcnt(0) lgkmcnt(0)" ::: "memory");
    __syncthreads();
    if (threadIdx.x == 0) {
        unsigned* bar = b.bar;
        __builtin_amdgcn_s_waitcnt(0);
        unsigned nloc = b.st[0], nx = b.st[1];
        if (nloc == 0u) { xcd_barrier_complete(bar, b.x, nloc, nx); b.st[0] = nloc; b.st[1] = nx; }
        const unsigned old = xb_add(&bar[XB_XSUB(b.x)], 1u);
        const unsigned gen = old / nloc;
        if (old + 1u == (gen + 1u) * nloc) {
            __builtin_amdgcn_fence(__ATOMIC_RELEASE, "agent");
            asm volatile("s_waitcnt vmcnt(0)" ::: "memory");
            const unsigned og = xb_add(&bar[XB_TOP], 1u);
            const unsigned tg = og / nx;
            if (og + 1u == (tg + 1u) * nx) xb_add(&bar[XB_TOPGEN], 1u);
            else XB_SPIN(xb_ld(&bar[XB_TOPGEN]) == tg, bar);
            __builtin_amdgcn_fence(__ATOMIC_ACQUIRE, "agent");
            xb_add(&bar[XB_XGEN(b.x)], 1u);
            asm volatile("s_waitcnt vmcnt(0)" ::: "memory");
        } else {
            XB_SPIN(xb_ld(&bar[XB_XGEN(b.x)]) == gen, bar);
            __builtin_amdgcn_fence(__ATOMIC_ACQUIRE, "agent");
            asm volatile("s_waitcnt vmcnt(0)" ::: "memory");
        }
    }
    __syncthreads();
    asm volatile("" ::: "memory");
}
__device__ __forceinline__ void grid_barrier_ctr(unsigned* cnt, unsigned& target, unsigned nblk) {
    asm volatile("s_waitcnt vmcnt(0) lgkmcnt(0)" ::: "memory");
    __builtin_amdgcn_s_barrier();
    target += nblk;
    if (threadIdx.x == 0) {
        __builtin_amdgcn_fence(__ATOMIC_RELEASE, "agent");
        asm volatile("s_waitcnt vmcnt(0)" ::: "memory");
        __hip_atomic_fetch_add(cnt, 1u, __ATOMIC_RELAXED, __HIP_MEMORY_SCOPE_AGENT);
        while (__hip_atomic_load(cnt, __ATOMIC_RELAXED, __HIP_MEMORY_SCOPE_AGENT) < target) __builtin_amdgcn_s_sleep(1);
        __builtin_amdgcn_fence(__ATOMIC_ACQUIRE, "agent");
        asm volatile("s_waitcnt vmcnt(0)" ::: "memory");
    }
    __builtin_amdgcn_s_barrier();
    asm volatile("" ::: "memory");
}
__device__ __forceinline__ void grid_barrier(cg::grid_group& grid) {
    asm volatile("s_waitcnt vmcnt(0) lgkmcnt(0)" ::: "memory");
    grid.sync();
    asm volatile("" ::: "memory");
}
struct Params { const float* in[18]; float* out; unsigned char* ws; };

__global__ void __launch_bounds__(512, 2) fwd_kernel(Params P) {
    extern __shared__ __attribute__((aligned(16))) unsigned char lds_raw[];
    LAS unsigned char* lds = (LAS unsigned char*)lds_raw;
    cg::grid_group grid = cg::this_grid();
    const int G = gridDim.x, bx = blockIdx.x;
    unsigned long long pb_t0 = 0, pb_acc = 0;
    unsigned* BARCNT = (unsigned*)(P.ws + OFF_BAR); unsigned bar_target = 0;
    volatile LAS unsigned* xb_st = (volatile LAS unsigned*)(lds + LDS_BYTES - 16);
    if (threadIdx.x == 0) { xb_st[0] = 0u; xb_st[1] = 0u; }
    __syncthreads();
    const XcdBarrier xbar = xcd_barrier_post(BARCNT, xb_st);
    unsigned char* ws = P.ws;
    bf16_t* W1IN = (bf16_t*)(ws + OFF_W1IN); bf16_t* W1OUT = (bf16_t*)(ws + OFF_W1OUT); bf16_t* WMIX = (bf16_t*)(ws + OFF_WMIX);
    bf16_t* WA = (bf16_t*)(ws + OFF_WA); bf16_t* WB = (bf16_t*)(ws + OFF_WB); bf16_t* WO = (bf16_t*)(ws + OFF_WO);
    bf16_t* W2IN = (bf16_t*)(ws + OFF_W2IN); bf16_t* W2OUT = (bf16_t*)(ws + OFF_W2OUT);
    bf16_t* XB = (bf16_t*)(ws + OFF_XB); bf16_t* PROJ = (bf16_t*)(ws + OFF_PROJ); bf16_t* HID = PROJ;
    float* LSE = (float*)(ws + OFF_LSE); float* ROPE = (float*)(ws + OFF_ROPE); float* LB = (float*)(ws + OFF_LB);
    float* OUT = P.out;
    bf16_t* OHG = (bf16_t*)(ws + OFF_OHG); bf16_t* ATTNC = (bf16_t*)(ws + OFF_ATTNC);
    bf16_t* ZF = (bf16_t*)(ws + OFF_PROJ + (size_t)MTOK * DFF * 2);
    bf16_t* ZM = OHG;

    TIC();
    {
        const int tid = opaque_tid(), lane = tid & 63, wave = __builtin_amdgcn_readfirstlane(tid >> 6), gw = bx * 8 + wave, ngw = G * 8;
        LAS float* scr = (LAS float*)(lds + wave * 8448);
        constexpr int I_IN = (DM / 64) * (2 * DFF / 32), I_OUT = (DFF / 64) * (DM / 32), I_MIX = (DM / 64) * (INC / 32), I_A = (DM / 64) * (DM / 32), I_B = (512 / 64) * (DM / 32);
        constexpr int NITEMS = 2 * (I_IN + I_OUT) + I_MIX + 2 * I_A + I_B;
        for (int it = gw; it < NITEMS; it += ngw) {
            int r = it;
            if (r < I_IN) { transpose_item(P.in[1], DM, 2 * DFF, W1IN, scr, r, lane, 1); continue; } r -= I_IN;
            if (r < I_OUT) { transpose_item(P.in[2], DFF, DM, W1OUT, scr, r, lane, 0); continue; } r -= I_OUT;
            if (r < I_MIX) { transpose_item(P.in[5], DM, INC, WMIX, scr, r, lane, 0); continue; } r -= I_MIX;
            if (r < I_A) { transpose_item(P.in[9], DM, DM, WA, scr, r, lane, 0); continue; } r -= I_A;
            if (r < I_B) { transpose_item(P.in[10], 512, DM, WB, scr, r, lane, 0); continue; } r -= I_B;
            if (r < I_A) { transpose_item(P.in[11], DM, DM, WO, scr, r, lane, 0); continue; } r -= I_A;
            if (r < I_IN) { transpose_item(P.in[14], DM, 2 * DFF, W2IN, scr, r, lane, 1); continue; } r -= I_IN;
            transpose_item(P.in[15], DFF, DM, W2OUT, scr, r, lane, 0);
        }
        const size_t nth = (size_t)G * 512, gt = (size_t)bx * 512 + tid;
        const f32x4* x4 = (const f32x4*)P.in[0];
        for (size_t i = gt; i < (size_t)MTOK * DM / 8; i += nth) { const f32x4 a = x4[2 * i], b = x4[2 * i + 1];
            u32x4 w; w.x = cvt_pk_bf16(a.x, a.y); w.y = cvt_pk_bf16(a.z, a.w); w.z = cvt_pk_bf16(b.x, b.y); w.w = cvt_pk_bf16(b.z, b.w); ((u32x4*)XB)[i] = w; }
        for (size_t i = gt; i < (size_t)SEQ * 16; i += nth) { const int pos = (int)(i >> 4), k = (int)(i & 15);
            const float invf = exp2f(-(float)k * (18.931568569324174f / 16.0f));
            const float ang = (float)pos * invf;
            const float kr = rintf(ang * 0.15915494309189535f);
            float rr = fmaf(-kr, 6.2831854820251465f, ang); rr = fmaf(-kr, -1.7484555e-7f, rr);
            ROPE[pos * 32 + k] = cosf(rr); ROPE[pos * 32 + 16 + k] = sinf(rr); }
        for (size_t i = gt; i < (size_t)2 * DM; i += nth) { const int dirr = (int)(i / DM), ch = (int)(i % DM); const float* tb = P.in[6 + dirr];
            LB[i] = 1.0f / (1.0f + expf(tb[DM + ch] - tb[ch])); }
    }
    TOC(PB_PRO);
    { TIC(); grid_barrier(grid); TOC(PB_BAR); }

#pragma unroll 1
    for (int f = 0; f < 2; ++f) {
        if (f == 1) {
#pragma unroll 1
            for (int hb = 0; hb < NHALF; ++hb) {
#ifdef SKIP_MIXER
                break;
#endif
                const size_t tok0 = (size_t)hb * MH;
                TIC();
                { pg8::Gemm g{XB + tok0 * DM, WMIX, MH, INC, DM, DM}; pg8::StaticOrder S; S.init(MH, INC, G, bx); pg8::EpiBf16 E{PROJ, PTILE};
                  pg8::gemm_phase<pg8::EpiBf16>(lds, g, S, E); }
                TOC(PB_GEMM_MIX);
                { TIC(); xcd_barrier(xbar); TOC(PB_BAR); }
                TIC();
#ifndef SKIP_HGRN
                for (int it = bx; it < BH * 16 * 2; it += G) hgrn_item(lds, PROJ, LB, it);
#endif
                TOC(PB_HGRN);
                TIC();
                attn_phase(lds, PROJ, LSE, ROPE, bx, G, 3 * BH * 4 * 32);
                TOC(PB_ATTN);
                { TIC(); xcd_barrier(xbar); TOC(PB_BAR); }
                TIC();
#ifndef SKIP_FIN
                mixer_finalize(PROJ, LSE, P.in[8], OHG, ATTNC);
#endif
                TOC(PB_FIN);
                { TIC(); xcd_barrier(xbar); TOC(PB_BAR); }
                TIC();
                bf16_t* MIXB = PROJ;
                { pg8::Gemm g{OHG, WA, MH, DM, DM, DM}; pg8::StaticOrder S; S.init(MH, DM, G, bx, 4); pg8::EpiGate<0> E{PROJ + pcol(C_GA), PTILE, MIXB, DM};
                  pg8::gemm_phase<pg8::EpiGate<0>>(lds, g, S, E); }
                { pg8::Gemm g{ATTNC, WB, MH, DM, 512, 512}; pg8::StaticOrder S; S.init(MH, DM, G, bx, 4); pg8::EpiGate<1> E{PROJ + pcol(C_GB), PTILE, MIXB, DM};
                  pg8::gemm_phase<pg8::EpiGate<1>>(lds, g, S, E); }
                TOC(PB_GEMM_MIX);
                { TIC(); xcd_barrier(xbar); TOC(PB_BAR); }
                TIC();
                { pg8::Gemm g{MIXB, WO, MH, DM, DM, DM}; pg8::StaticOrder S; S.init(MH, DM, G, bx, 4); pg8::EpiScaleBf16 E{ZM, DM, 1.0f};
                  pg8::gemm_phase<pg8::EpiScaleBf16>(lds, g, S, E); }
                TOC(PB_GEMM_MIX);
                { TIC(); xcd_barrier(xbar); TOC(PB_BAR); }
                TIC();
                ln_rows<true>(XB, ZM, nullptr, XB, P.in[12], P.in[13], (int)tok0, MH);
                TOC(PB_LN);
                if (hb == NHALF - 1) { TIC(); xcd_barrier(xbar); TOC(PB_BAR); }
            }
        }
#pragma unroll 1
        for (int th = 0; th < 2; ++th) {
            const size_t r0 = (size_t)th * MH;
            TIC();
            { pg8::Gemm g{XB + r0 * DM, f ? W2IN : W1IN, MH, 2 * DFF, DM, DM}; pg8::StaticOrder S; S.init(MH, 2 * DFF, G, bx); pg8::EpiSwiglu E{HID + r0 * DFF, DFF};
              pg8::gemm_phase<pg8::EpiSwiglu>(lds, g, S, E); }
            TOC(PB_GEMM_FFN);
            { TIC(); xcd_barrier(xbar); TOC(PB_BAR); }
            TIC();
            { pg8::Gemm g{HID + r0 * DFF, f ? W2OUT : W1OUT, MH, DM, DFF, DFF}; pg8::StaticOrder S; S.init(MH, DM, G, bx, 4); pg8::EpiScaleBf16 E{ZF + r0 * DM, DM, 0.5f};
              pg8::gemm_phase<pg8::EpiScaleBf16>(lds, g, S, E); }
            TOC(PB_GEMM_FFN);
        }
        { TIC(); xcd_barrier(xbar); TOC(PB_BAR); }
        TIC();
        if (f == 0) ln_rows<false>(P.in[0], ZF, nullptr, XB, P.in[3], P.in[4], 0, MTOK);
        else ln_rows<true>(XB, ZF, OUT, nullptr, P.in[16], P.in[17], 0, MTOK);
        TOC(PB_LN);
        if (f == 0) { TIC(); xcd_barrier(xbar); TOC(PB_BAR); }
    }
    if (PROBE_MASK) {
        unsigned long long* pw = (unsigned long long*)(P.ws + OFF_BAR + 64);
        if (PROBE_MODE != 0) {
            if (threadIdx.x == 0) atomicMax(pw, PROBE_MODE == 1 ? pb_acc : ((1ull << 40) - pb_acc));
            grid_barrier_ctr(BARCNT, bar_target, (unsigned)G);
            if (threadIdx.x == 0) { const unsigned long long v = __hip_atomic_load(pw, __ATOMIC_RELAXED, __HIP_MEMORY_SCOPE_AGENT); pb_acc = PROBE_MODE == 1 ? v : ((1ull << 40) - v); }
        }
        if (bx == 0 && threadIdx.x == 0) { const unsigned long long t1 = __builtin_amdgcn_s_memrealtime(); while (__builtin_amdgcn_s_memrealtime() - t1 < pb_acc) __builtin_amdgcn_s_sleep(8); }
    }
}

extern "C" void kernel_launch(void* const* d_in, const int* in_sizes, int n_in, void* d_out, int out_size, void* d_ws, size_t ws_size, hipStream_t stream) {
    static int grid_blocks = 0;
    if (grid_blocks == 0) {
        if (n_in != 18 || ws_size < WS_END2) { fprintf(stderr, "kernel_launch: need 18 inputs and >= %zu bytes of workspace; got %d, %zu\n", (size_t)WS_END2, n_in, ws_size); grid_blocks = -1; return; }
        int dev = 0, cus = 0, per_cu = 0;
        hipGetDevice(&dev);
        hipDeviceGetAttribute(&cus, hipDeviceAttributeMultiprocessorCount, dev);
        if (hipFuncSetAttribute((const void*)fwd_kernel, hipFuncAttributeMaxDynamicSharedMemorySize, LDS_BYTES) != hipSuccess) fprintf(stderr, "kernel_launch: hipFuncSetAttribute failed\n");
        hipOccupancyMaxActiveBlocksPerMultiprocessor(&per_cu, (const void*)fwd_kernel, 512, LDS_BYTES);
        if (per_cu < 1) { fprintf(stderr, "kernel_launch: occupancy query says %d blocks per CU\n", per_cu); per_cu = 1; }
        (void)hipGetLastError();
        grid_blocks = cus * per_cu;
    }
    if (grid_blocks < 0) return;
    (void)hipMemsetAsync((char*)d_ws + OFF_BAR, 0, BAR_BYTES, stream);
    Params p{};
    for (int i = 0; i < 18; ++i) p.in[i] = (const float*)d_in[i];
    p.out = (float*)d_out; p.ws = (unsigned char*)d_ws;
    void* args[] = {&p};
    hipError_t e = hipLaunchCooperativeKernel((const void*)fwd_kernel, dim3(grid_blocks), dim3(512), args, LDS_BYTES, stream);
    if (e != hipSuccess) fprintf(stderr, "cooperative launch failed: %s (grid %d)\n", hipGetErrorString(e), grid_blocks);
}
```

```cpp
#include <hip/hip_runtime.h>
#include <hip/hip_cooperative_groups.h>
#include <cstdio>
namespace cg = cooperative_groups;

#define LAS __attribute__((address_space(3)))
typedef unsigned short bf16_t;
typedef short bf16x8 __attribute__((ext_vector_type(8)));
typedef float f32x4 __attribute__((ext_vector_type(4)));
typedef unsigned u32x4 __attribute__((ext_vector_type(4)));
typedef unsigned u32x2 __attribute__((ext_vector_type(2)));

constexpr int SEQ = 2048, NBATCH = 16, MTOK = NBATCH * SEQ, DM = 2048, DFF = 5632, INC = 18944;
constexpr int NHALF = 2, BH = NBATCH / NHALF, MH = BH * SEQ;
constexpr int C_HQ = 0, C_HFF = 2048, C_HFB = 4096, C_HI = 6144, C_HOG = 8192, C_QKV = 10240, C_GA = 14848, C_GB = 16896;
constexpr float LN_EPS = 1e-5f;
constexpr float DN_ALPHA = 1.189207115002721f;

constexpr size_t SZ_WIN = (size_t)2 * DFF * DM * 2, SZ_WOUT = (size_t)DM * DFF * 2, SZ_WMIX = (size_t)INC * DM * 2;
constexpr size_t SZ_WA = (size_t)DM * DM * 2, SZ_WB = (size_t)DM * 512 * 2;
constexpr size_t OFF_W1IN = 0, OFF_W1OUT = OFF_W1IN + SZ_WIN, OFF_WMIX = OFF_W1OUT + SZ_WOUT, OFF_WA = OFF_WMIX + SZ_WMIX, OFF_WB = OFF_WA + SZ_WA,
                 OFF_WO = OFF_WB + SZ_WB, OFF_W2IN = OFF_WO + SZ_WA, OFF_W2OUT = OFF_W2IN + SZ_WIN, OFF_XB = OFF_W2OUT + SZ_WOUT,
                 OFF_PROJ = OFF_XB + (size_t)MTOK * DM * 2, SZ_PROJ = (size_t)MH * INC * 2, OFF_LSE = OFF_PROJ + SZ_PROJ,
                 OFF_ROPE = OFF_LSE + (size_t)3 * MH * 4 * 4, OFF_LB = OFF_ROPE + (size_t)SEQ * 32 * 4, WS_END = OFF_LB + (size_t)2 * DM * 4;
static_assert((size_t)MTOK * DFF * 2 + (size_t)MTOK * DM * 2 <= SZ_PROJ, "hidden + FFN branch output alias the projection buffer");
constexpr size_t OFF_BAR = (WS_END + 255) / 256 * 256, BAR_BYTES = 16384, OFF_ATTNC = OFF_BAR + BAR_BYTES, WS_END2 = OFF_ATTNC + (size_t)MH * 512 * 2;
constexpr size_t OFF_OHG = OFF_W1IN;
static_assert((size_t)MH * DM * 2 <= OFF_WMIX - OFF_W1IN, "dense HGRN output must fit in the FFN1 weight region");
constexpr int LDS_BYTES = 147456;

typedef __bf16 bf16x2_t __attribute__((ext_vector_type(2)));
typedef float f32x2_t __attribute__((ext_vector_type(2)));
__device__ __forceinline__ unsigned cvt_pk_bf16(float lo, float hi) { const f32x2_t v = {lo, hi}; const bf16x2_t b = __builtin_convertvector(v, bf16x2_t); return __builtin_bit_cast(unsigned, b); }
__device__ __forceinline__ bf16_t f2bf(float x) { return (bf16_t)(cvt_pk_bf16(x, 0.f) & 0xffffu); }
__device__ __forceinline__ float bf_lo(unsigned w) { return __uint_as_float(w << 16); }
__device__ __forceinline__ float bf_hi(unsigned w) { return __uint_as_float(w & 0xffff0000u); }
__device__ __forceinline__ float bf2f(bf16_t b) { return __uint_as_float(((unsigned)b) << 16); }
__device__ __forceinline__ float sigmoidf_(float x) { return __builtin_amdgcn_rcpf(1.0f + __expf(-x)); }
__device__ __forceinline__ float siluf_(float x) { return x * sigmoidf_(x); }
__device__ __forceinline__ void unpack8(const u32x4 w, float (&f)[8]) {
    f[0] = bf_lo(w.x); f[1] = bf_hi(w.x); f[2] = bf_lo(w.y); f[3] = bf_hi(w.y); f[4] = bf_lo(w.z); f[5] = bf_hi(w.z); f[6] = bf_lo(w.w); f[7] = bf_hi(w.w);
}
__device__ __forceinline__ u32x4 pack8(const float (&f)[8]) {
    u32x4 w; w.x = cvt_pk_bf16(f[0], f[1]); w.y = cvt_pk_bf16(f[2], f[3]); w.z = cvt_pk_bf16(f[4], f[5]); w.w = cvt_pk_bf16(f[6], f[7]); return w;
}
__device__ __forceinline__ float wave_sum(float v) {
#pragma unroll
    for (int o = 1; o < 64; o <<= 1) v += __shfl_xor(v, o);
    return v;
}
#define LDS_WAIT() asm volatile("s_waitcnt lgkmcnt(0)" ::: "memory")
constexpr size_t PTILE = (size_t)MH * 256;
__device__ __forceinline__ size_t pcol(int c) { return (size_t)(c >> 8) * PTILE + (size_t)(c & 255); }
#define BAR_LDS() do { asm volatile("s_waitcnt lgkmcnt(0)" ::: "memory"); __builtin_amdgcn_s_barrier(); asm volatile("" ::: "memory"); } while (0)
__device__ __forceinline__ int opaque_tid() { int t = threadIdx.x; asm volatile("" : "+v"(t)); return t; }

namespace pg8 {
constexpr int BM = 256, BK = 64, HALF = 128, HTB = HALF * BK * 2, STAGE_BYTES = 8 * HTB, NXCD = 8, WGM = 8;
__host__ __device__ __forceinline__ int lds_byte(int r, int c) { const int st = (r >> 4) * 2 + (c >> 5), rr = r & 15, cc = c & 31, ob = rr * 64 + cc * 2; return st * 1024 + (ob ^ (((ob >> 9) & 1) << 5)); }
__host__ __device__ __forceinline__ void stage_rc(int b, int& R, int& C) { const int st = b / 1024, sb = b % 1024, swz = sb ^ (((sb >> 9) & 1) << 5); R = (st >> 1) * 16 + swz / 64; C = (st & 1) * 32 + (swz % 64) / 2; }
__host__ __device__ __forceinline__ int perm32(int rho) { const int n = rho >> 4, i = rho & 15; return 8 * (i >> 2) + 4 * n + (i & 3); }

struct Unit { int pm, pn; };
struct Gemm { const bf16_t* A; const bf16_t* Bt; int M, N, K, lda; };

struct StaticOrder {
    int nM, nN, nwg, G, c, wgm;
    __device__ void init(int M, int N, int G_, int c_, int wgm_ = WGM) { nM = M / BM; nN = N / BM; nwg = nM * nN; G = G_; c = c_; wgm = wgm_; }
    __device__ bool next(int i, Unit& u) const {
        const long L = (long)i * G + c; if (L >= nwg) return false;
        int wgid = (int)L; { const int q = nwg / NXCD, r = nwg % NXCD, xcd = wgid % NXCD, off = wgid / NXCD; wgid = (xcd < r ? xcd * (q + 1) : r * (q + 1) + (xcd - r) * q) + off; }
        const int nig = wgm * nN, gid = wgid / nig, fm = gid * wgm, gsz = (nM - fm) < wgm ? (nM - fm) : wgm;
        u.pm = fm + ((wgid % nig) % gsz); u.pn = (wgid % nig) / gsz; return true;
    }
};

struct EpiBf16 {
    static constexpr bool PERM = true;
    bf16_t* O; size_t tile_elems;
    __device__ __forceinline__ void operator()(const f32x4 (&acc)[2][2][4][2], const Unit& u, int wr, int wc, int fr, int fq) const {
        const int row0 = u.pm * BM + wr * 64 + fr, col0 = wc * 32 + 8 * fq;
#pragma unroll
        for (int ai = 0; ai < 2; ++ai)
#pragma unroll
            for (int m = 0; m < 4; ++m) { bf16_t* rowp = O + (size_t)u.pn * tile_elems + (size_t)(row0 + ai * HALF + m * 16) * 256 + col0;
#pragma unroll
                for (int bj = 0; bj < 2; ++bj) { const f32x4 v0 = acc[ai][bj][m][0], v1 = acc[ai][bj][m][1];
                    u32x4 w; w.x = cvt_pk_bf16(v0[0], v0[1]); w.y = cvt_pk_bf16(v0[2], v0[3]); w.z = cvt_pk_bf16(v1[0], v1[1]); w.w = cvt_pk_bf16(v1[2], v1[3]);
                    *(u32x4*)(rowp + bj * HALF) = w; } }
    }
};
struct EpiScaleBf16 {
    static constexpr bool PERM = true;
    bf16_t* O; int ldc; float scale;
    __device__ __forceinline__ void operator()(const f32x4 (&acc)[2][2][4][2], const Unit& u, int wr, int wc, int fr, int fq) const {
        const int row0 = u.pm * BM + wr * 64 + fr, col0 = u.pn * BM + wc * 32 + 8 * fq;
#pragma unroll
        for (int ai = 0; ai < 2; ++ai)
#pragma unroll
            for (int m = 0; m < 4; ++m) { bf16_t* rowp = O + (size_t)(row0 + ai * HALF + m * 16) * ldc + col0;
#pragma unroll
                for (int bj = 0; bj < 2; ++bj) { const f32x4 v0 = acc[ai][bj][m][0] * scale, v1 = acc[ai][bj][m][1] * scale;
                    u32x4 w; w.x = cvt_pk_bf16(v0[0], v0[1]); w.y = cvt_pk_bf16(v0[2], v0[3]); w.z = cvt_pk_bf16(v1[0], v1[1]); w.w = cvt_pk_bf16(v1[2], v1[3]);
                    *(u32x4*)(rowp + bj * HALF) = w; } }
    }
};
struct EpiSwiglu {
    static constexpr bool PERM = true;
    bf16_t* O; int ldc;
    __device__ __forceinline__ void operator()(const f32x4 (&acc)[2][2][4][2], const Unit& u, int wr, int wc, int fr, int fq) const {
        const int row0 = u.pm * BM + wr * 64 + fr, col0 = u.pn * HALF + wc * 32 + 8 * fq;
#pragma unroll
        for (int ai = 0; ai < 2; ++ai)
#pragma unroll
            for (int m = 0; m < 4; ++m) { bf16_t* rowp = O + (size_t)(row0 + ai * HALF + m * 16) * ldc + col0;
                float h[8];
#pragma unroll
                for (int n = 0; n < 2; ++n)
#pragma unroll
                    for (int j = 0; j < 4; ++j) h[4 * n + j] = siluf_(acc[ai][0][m][n][j]) * acc[ai][1][m][n][j];
                *(u32x4*)rowp = pack8(h); }
    }
};
struct EpiResF32 {
    static constexpr bool PERM = false;
    const float* res; float* out; int ldc; float alpha, scale;
    __device__ __forceinline__ void operator()(const f32x4 (&acc)[2][2][4][2], const Unit& u, int wr, int wc, int fr, int fq) const {
        const int row0 = u.pm * BM + wr * 64 + fr, col0 = u.pn * BM + wc * 32 + 4 * fq;
#pragma unroll
        for (int ai = 0; ai < 2; ++ai)
#pragma unroll
            for (int m = 0; m < 4; ++m) { const size_t off = (size_t)(row0 + ai * HALF + m * 16) * ldc + col0;
#pragma unroll
                for (int bj = 0; bj < 2; ++bj)
#pragma unroll
                    for (int n = 0; n < 2; ++n) { const size_t o = off + bj * HALF + n * 16; const f32x4 r = *(const f32x4*)(res + o); *(f32x4*)(out + o) = r * alpha + acc[ai][bj][m][n] * scale; } }
    }
};
template <int MODE> struct EpiGate {
    static constexpr bool PERM = true;
    const bf16_t* G; size_t tile_elems; bf16_t* O; int ldo;
    __device__ __forceinline__ void operator()(const f32x4 (&acc)[2][2][4][2], const Unit& u, int wr, int wc, int fr, int fq) const {
        const int row0 = u.pm * BM + wr * 64 + fr, col0 = u.pn * BM + wc * 32 + 8 * fq;
#pragma unroll
        for (int ai = 0; ai < 2; ++ai)
#pragma unroll
            for (int m = 0; m < 4; ++m) { const size_t row = (size_t)(row0 + ai * HALF + m * 16);
#pragma unroll
                for (int bj = 0; bj < 2; ++bj) { const bf16_t* gp = G + (size_t)u.pn * tile_elems + row * 256 + (wc * 32 + 8 * fq) + bj * HALF; bf16_t* op = O + row * ldo + col0 + bj * HALF; float s[8], g[8], o[8];
                    unpack8(*(const u32x4*)gp, g);
                    if (MODE == 1) unpack8(*(const u32x4*)op, s);
#pragma unroll
                    for (int j = 0; j < 8; ++j) { const float a = acc[ai][bj][m][j >> 2][j & 3]; o[j] = (MODE == 0) ? sigmoidf_(g[j]) * a : s[j] + sigmoidf_(g[j]) * a; }
                    *(u32x4*)op = pack8(o); } }
    }
};

template <class Epi>
__device__ __forceinline__ void gemm_phase(LAS unsigned char* lds, const Gemm g, const StaticOrder& S, const Epi& E) {
    const int tid = opaque_tid(), wid = __builtin_amdgcn_readfirstlane(tid >> 6), lane = tid & 63, wr = wid >> 2, wc = wid & 3, fr = lane & 15, fq = lane >> 4;
    const int K = g.K, nt = K / BK, lda = g.lda;
    unsigned voffA[2], voffB[2];
#pragma unroll
    for (int i = 0; i < 2; ++i) { int R, C; stage_rc(tid * 16 + i * 8192, R, C); const int Rb = Epi::PERM ? ((R & ~31) + perm32(R & 31)) : R;
        voffA[i] = (unsigned)(R * lda + C) * 2u; voffB[i] = (unsigned)(Rb * K + C) * 2u; }
    const size_t kstep = (size_t)(BK * 2);
    const size_t hstepA = (size_t)HALF * lda * 2, hstepB = (size_t)HALF * K * 2;
    const size_t tstepA = 2 * hstepA, tstepB = 2 * hstepB;
    const unsigned ldsw = (unsigned)wid * 1024u;
    const int aoff = lds_byte(wr * 64 + fr, fq * 8), boff = lds_byte(wc * 32 + fr, fq * 8);
#define PG8_SA(b, h) (((b) * 2 + (h)) * HTB)
#define PG8_SB(b, h) ((4 + (b) * 2 + (h)) * HTB)
#define PG8_STAGE(bufoff, gbase, voff) do { _Pragma("unroll") for (int _i = 0; _i < 2; ++_i) \
        __builtin_amdgcn_global_load_lds((const unsigned*)((const char*)(gbase) + (voff)[_i]), (LAS unsigned*)(lds + (bufoff) + ldsw + _i * 8192), 16, 0, 0); } while (0)
#define PG8_LDA(dst, b, h) do { _Pragma("unroll") for (int m = 0; m < 4; ++m) _Pragma("unroll") for (int k = 0; k < 2; ++k) dst[m][k] = *(const LAS bf16x8*)(lds + PG8_SA(b, h) + aoff + m * 2048 + k * 1024); } while (0)
#define PG8_LDB(dst, b, h) do { _Pragma("unroll") for (int n = 0; n < 2; ++n) _Pragma("unroll") for (int k = 0; k < 2; ++k) dst[n][k] = *(const LAS bf16x8*)(lds + PG8_SB(b, h) + boff + n * 2048 + k * 1024); } while (0)
#define PG8_MMA(ai, bj, At, Bt) do { __builtin_amdgcn_s_setprio(1); _Pragma("unroll") for (int m = 0; m < 4; ++m) _Pragma("unroll") for (int n = 0; n < 2; ++n) _Pragma("unroll") for (int k = 0; k < 2; ++k) \
        acc[ai][bj][m][n] = __builtin_amdgcn_mfma_f32_16x16x32_bf16(Bt[n][k], At[m][k], acc[ai][bj][m][n], 0, 0, 0); __builtin_amdgcn_s_setprio(0); } while (0)
#define PG8_WAIT_V(n) asm volatile("s_waitcnt vmcnt(" #n ")" ::: "memory")
#define PG8_WAIT_L(n) asm volatile("s_waitcnt lgkmcnt(" #n ")" ::: "memory")
#define PG8_BAR __builtin_amdgcn_s_barrier()
#define PG8_SCHED __builtin_amdgcn_sched_barrier(0)
    Unit cur, nxt; int ui = 0;
    if (!S.next(0, cur)) return;
    f32x4 acc[2][2][4][2];
#pragma unroll
    for (int a = 0; a < 2; ++a)
#pragma unroll
        for (int b = 0; b < 2; ++b)
#pragma unroll
            for (int m = 0; m < 4; ++m)
#pragma unroll
                for (int n = 0; n < 2; ++n) acc[a][b][m][n] = (f32x4){0.f, 0.f, 0.f, 0.f};
    bf16x8 At[4][2], B0[2][2], B1[2][2];
    const char* cA = (const char*)g.A + (size_t)cur.pm * tstepA; const char* cB = (const char*)g.Bt + (size_t)cur.pn * tstepB;
    PG8_STAGE(PG8_SB(0, 0), cB, voffB); PG8_STAGE(PG8_SB(0, 1), cB + hstepB, voffB); PG8_STAGE(PG8_SA(0, 0), cA, voffA); PG8_STAGE(PG8_SA(0, 1), cA + hstepA, voffA);
    if (wr == 1) PG8_BAR;
    PG8_WAIT_V(2); PG8_BAR;
    PG8_STAGE(PG8_SB(1, 0), cB + kstep, voffB); PG8_STAGE(PG8_SA(1, 0), cA + kstep, voffA); PG8_STAGE(PG8_SB(1, 1), cB + hstepB + kstep, voffB);
    PG8_WAIT_V(6); PG8_BAR;
    for (;;) {
        const bool has_next = S.next(ui + 1, nxt);
        const char* nA = has_next ? (const char*)g.A + (size_t)nxt.pm * tstepA : cA; const char* nB = has_next ? (const char*)g.Bt + (size_t)nxt.pn * tstepB : cB;
        for (int t = 0; t < nt; t += 2) {
            const bool last = (t == nt - 2);
            const char* a1 = cA + (size_t)(t + 1) * kstep;
            const char* a2 = last ? nA : cA + (size_t)(t + 2) * kstep; const char* b2 = last ? nB : cB + (size_t)(t + 2) * kstep;
            const char* a3 = a2 + kstep; const char* b3 = b2 + kstep;
            PG8_LDB(B0, 0, 0); PG8_LDB(B1, 0, 1); PG8_SCHED; PG8_LDA(At, 0, 0); PG8_STAGE(PG8_SA(1, 1), a1 + hstepA, voffA);
            PG8_WAIT_V(8); PG8_WAIT_L(0); PG8_BAR; PG8_MMA(0, 0, At, B0); PG8_MMA(0, 1, At, B1); PG8_BAR; PG8_SCHED;
            PG8_LDA(At, 0, 1); PG8_STAGE(PG8_SB(0, 0), b2, voffB); PG8_STAGE(PG8_SB(0, 1), b2 + hstepB, voffB); PG8_STAGE(PG8_SA(0, 0), a2, voffA);
            PG8_WAIT_V(8); PG8_WAIT_L(0); PG8_BAR; PG8_MMA(1, 0, At, B0); PG8_MMA(1, 1, At, B1); PG8_BAR; PG8_SCHED;
            PG8_LDB(B0, 1, 0); PG8_LDB(B1, 1, 1); PG8_SCHED; PG8_LDA(At, 1, 0); PG8_STAGE(PG8_SA(0, 1), a2 + hstepA, voffA);
            PG8_WAIT_V(8); PG8_WAIT_L(0); PG8_BAR; PG8_MMA(0, 0, At, B0); PG8_MMA(0, 1, At, B1); PG8_BAR; PG8_SCHED;
            PG8_LDA(At, 1, 1); PG8_STAGE(PG8_SB(1, 0), b3, voffB); PG8_STAGE(PG8_SB(1, 1), b3 + hstepB, voffB); PG8_STAGE(PG8_SA(1, 0), a3, voffA);
            PG8_WAIT_V(8); PG8_WAIT_L(0); PG8_BAR; PG8_MMA(1, 0, At, B0); PG8_MMA(1, 1, At, B1); PG8_BAR; PG8_SCHED;
        }
        if (wr == 0) PG8_BAR;
        E(acc, cur, wr, wc, fr, fq);
        if (!has_next) break;
#pragma unroll
        for (int a = 0; a < 2; ++a)
#pragma unroll
            for (int b = 0; b < 2; ++b)
#pragma unroll
                for (int m = 0; m < 4; ++m)
#pragma unroll
                    for (int n = 0; n < 2; ++n) acc[a][b][m][n] = (f32x4){0.f, 0.f, 0.f, 0.f};
        cur = nxt; cA = nA; cB = nB; ++ui;
        if (wr == 1) PG8_BAR;
    }
    PG8_WAIT_V(0);
    PG8_BAR;
#undef PG8_SA
#undef PG8_SB
#undef PG8_STAGE
#undef PG8_LDA
#undef PG8_LDB
#undef PG8_MMA
#undef PG8_WAIT_V
#undef PG8_WAIT_L
#undef PG8_BAR
#undef PG8_SCHED
}
}

__device__ __forceinline__ void transpose_item(const float* W, int K, int N, bf16_t* WT, LAS float* scr, int item, int lane, int mode) {
    const int nblk = N / 32, kb = item / nblk, nb = item % nblk, k0 = 64 * kb, n0 = 32 * nb;
    int drow0 = n0;
    if (mode == 1) { if (n0 < DFF) drow0 = 256 * (n0 / 128) + (n0 % 128); else { const int n1 = n0 - DFF; drow0 = 256 * (n1 / 128) + 128 + (n1 % 128); } }
#pragma unroll 8
    for (int i = 0; i < 32; ++i) { const int kk = 2 * i + (lane >> 5); scr[kk * 33 + (lane & 31)] = W[(size_t)(k0 + kk) * N + n0 + (lane & 31)]; }
    LDS_WAIT();
    const int c = lane & 7;
#pragma unroll
    for (int j = 0; j < 4; ++j) { const int n = (lane >> 3) + 8 * j; const LAS float* s = scr + (8 * c) * 33 + n;
        u32x4 o; o.x = cvt_pk_bf16(s[0 * 33], s[1 * 33]); o.y = cvt_pk_bf16(s[2 * 33], s[3 * 33]); o.z = cvt_pk_bf16(s[4 * 33], s[5 * 33]); o.w = cvt_pk_bf16(s[6 * 33], s[7 * 33]);
        *(u32x4*)(WT + (size_t)(drow0 + n) * K + k0 + 8 * c) = o; }
    LDS_WAIT();
}

template <bool HB> struct LnIn { };
template <> struct LnIn<false> { f32x4 x[8]; };
template <> struct LnIn<true> { u32x2 x[8]; };
template <bool HB> __device__ __forceinline__ void ln_load(const void* hin, const bf16_t* z, int m, int mm, int lane, LnIn<HB>& r, u32x2 (&zz)[8]) {
    const u32x2* zr = (const u32x2*)(z + (size_t)mm * DM) + lane;
    if constexpr (HB) { const u32x2* xr = (const u32x2*)((const bf16_t*)hin + (size_t)m * DM) + lane;
#pragma unroll
        for (int j = 0; j < 8; ++j) { r.x[j] = xr[64 * j]; zz[j] = zr[64 * j]; } }
    else { const f32x4* xr = (const f32x4*)((const float*)hin + (size_t)m * DM) + lane;
#pragma unroll
        for (int j = 0; j < 8; ++j) { r.x[j] = xr[64 * j]; zz[j] = zr[64 * j]; } }
}
template <bool HB> __device__ __forceinline__ void ln_finish(const LnIn<HB>& r, const u32x2 (&zz)[8], float* outf, bf16_t* outb, const float* g, const float* b, int m, int lane) {
    f32x4 v[8]; float s = 0.f;
#pragma unroll
    for (int j = 0; j < 8; ++j) { f32x4 x;
        if constexpr (HB) x = (f32x4){bf_lo(r.x[j].x), bf_hi(r.x[j].x), bf_lo(r.x[j].y), bf_hi(r.x[j].y)}; else x = r.x[j];
        v[j] = x * DN_ALPHA + (f32x4){bf_lo(zz[j].x), bf_hi(zz[j].x), bf_lo(zz[j].y), bf_hi(zz[j].y)}; s += (v[j].x + v[j].y) + (v[j].z + v[j].w); }
    const float mean = wave_sum(s) * (1.f / DM); float s2 = 0.f;
#pragma unroll
    for (int j = 0; j < 8; ++j) { v[j] = v[j] - mean; s2 += (v[j].x * v[j].x + v[j].y * v[j].y) + (v[j].z * v[j].z + v[j].w * v[j].w); }
    const float rstd = 1.0f / sqrtf(wave_sum(s2) * (1.f / DM) + LN_EPS);
#pragma unroll
    for (int j = 0; j < 8; ++j) { const f32x4 gv = ((const f32x4*)g)[lane + 64 * j], bv = ((const f32x4*)b)[lane + 64 * j];
        const f32x4 o = v[j] * rstd * gv + bv;
        if (outf) ((f32x4*)(outf + (size_t)m * DM) + lane)[64 * j] = o;
        if (outb) { u32x2 w; w.x = cvt_pk_bf16(o.x, o.y); w.y = cvt_pk_bf16(o.z, o.w); *((u32x2*)(outb + (size_t)m * DM) + lane + 64 * j) = w; } }
}
template <bool HB> __device__ __forceinline__ void ln_rows(const void* hin, const bf16_t* z, float* outf, bf16_t* outb, const float* g, const float* b, int row0, int nrows) {
    const int tid = opaque_tid(), lane = tid & 63, gw = blockIdx.x * 8 + (tid >> 6), ngw = gridDim.x * 8;
    LnIn<HB> xa, xb; u32x2 za[8], zb[8];
    int mm = gw;
    if (mm < nrows) ln_load<HB>(hin, z, row0 + mm, mm, lane, xa, za);
    while (mm < nrows) {
        const int m1 = mm + ngw, m2 = m1 + ngw;
        if (m1 < nrows) ln_load<HB>(hin, z, row0 + m1, m1, lane, xb, zb);
        ln_finish<HB>(xa, za, outf, outb, g, b, row0 + mm, lane);
        if (m1 >= nrows) break;
        if (m2 < nrows) ln_load<HB>(hin, z, row0 + m2, m2, lane, xa, za);
        ln_finish<HB>(xb, zb, outf, outb, g, b, row0 + m1, lane);
        mm = m2;
    }
}

constexpr int HG_BUF = 38656, HG_QD = 0, HG_KD = 8832, HG_VT = 17664, HG_KET = 27904, HG_DEC = 38144, HG_ST = 2 * HG_BUF, HG_END = HG_ST + 34816;
__device__ __forceinline__ int hg_row(int r) { return r * 136 + (r >> 3) * 16; }
static_assert(HG_END <= LDS_BYTES, "hgrn lds");
typedef short bf16x4 __attribute__((ext_vector_type(4)));
__device__ __forceinline__ void hgrn_step(LAS unsigned char* lds, const bf16_t* __restrict__ uq, const bf16_t* __restrict__ ufi, bf16_t* __restrict__ ufo, const bf16_t* __restrict__ uv, unsigned voff, unsigned soff, int n, int dir, int wid, int fr, int fq, int d, float lb,
                                          bf16_t (&rq)[8], bf16_t (&rf)[8], bf16_t (&rv)[8], f32x4 (&sacc)[8]) {
    LAS bf16_t* ST = (LAS bf16_t*)(lds + HG_ST);
    {
        LAS unsigned char* B = lds + (n & 1) * HG_BUF;
        LAS bf16_t* QD = (LAS bf16_t*)(B + HG_QD); LAS bf16_t* KD = (LAS bf16_t*)(B + HG_KD); LAS bf16_t* VT = (LAS bf16_t*)(B + HG_VT); LAS bf16_t* KET = (LAS bf16_t*)(B + HG_KET);
        LAS float* DEC = (LAS float*)(B + HG_DEC);
        float q[8], k[8], v[8], cum[8]; float run = 0.f;
#pragma unroll
        for (int i = 0; i < 8; ++i) { q[i] = siluf_(bf2f(rq[i])); const float f = lb + (1.0f - lb) * sigmoidf_(bf2f(rf[i])); k[i] = 1.0f - f; run += __builtin_amdgcn_logf(f); cum[i] = run;     v[i] = bf2f(rv[i]); }
        {
            const int np = (n + 2 < SEQ / 32) ? (n + 2) : (SEQ / 32 - 1);
#pragma unroll
            for (int i = 0; i < 8; ++i) { const int ut = dir ? (SEQ - 1 - 24 - 32 * np - i) : (32 * np + i);
                const size_t ro = (size_t)ut * 256; rq[i] = (uq + ro)[voff]; rf[i] = (ufi + ro)[voff]; rv[i] = (uv + ro)[voff]; } }
        const float T0 = __shfl(run, fr), T1 = __shfl(run, 16 + fr), T2 = __shfl(run, 32 + fr), T3 = __shfl(run, 48 + fr);
        const float pre = (fq > 0 ? T0 : 0.f) + (fq > 1 ? T1 : 0.f) + (fq > 2 ? T2 : 0.f), tot = (T0 + T1) + (T2 + T3);
        float ke[8];
#pragma unroll
        for (int i = 0; i < 8; ++i) { const float c = cum[i] + pre; QD[hg_row(8 * fq + i) + d] = f2bf(q[i] * __builtin_amdgcn_exp2f(c)); KD[hg_row(8 * fq + i) + d] = f2bf(k[i] * __builtin_amdgcn_exp2f(-c)); ke[i] = k[i] * __builtin_amdgcn_exp2f(tot - c); }
        *(LAS u32x4*)(VT + d * 40 + 8 * fq) = pack8(v); *(LAS u32x4*)(KET + d * 40 + 8 * fq) = pack8(ke);
        if (fq == 0) DEC[d] = __builtin_amdgcn_exp2f(tot);
        BAR_LDS();
        const bf16x8 vB = *(const LAS bf16x8*)(VT + (16 * wid + fr) * 40 + 8 * fq);
        const bf16x4 vlo = *(const LAS bf16x4*)(VT + (16 * wid + fr) * 40 + 4 * fq), vhi = *(const LAS bf16x4*)(VT + (16 * wid + fr) * 40 + 16 + 4 * fq);
        const bf16x8 vBp = __builtin_shufflevector(vlo, vhi, 0, 1, 2, 3, 4, 5, 6, 7);
#pragma unroll
        for (int ct = 0; ct < 2; ++ct) {
            bf16x8 qf[4];
#pragma unroll
            for (int kk = 0; kk < 4; ++kk) qf[kk] = *(const LAS bf16x8*)(QD + hg_row(16 * ct + fr) + 32 * kk + 8 * fq);
            f32x4 at0 = (f32x4){0.f, 0.f, 0.f, 0.f}, at1 = (f32x4){0.f, 0.f, 0.f, 0.f};
#pragma unroll
            for (int kk = 0; kk < 4; ++kk) { const bf16x8 kf = *(const LAS bf16x8*)(KD + hg_row(fr) + 32 * kk + 8 * fq); at0 = __builtin_amdgcn_mfma_f32_16x16x32_bf16(kf, qf[kk], at0, 0, 0, 0); }
            if (ct == 1) {
#pragma unroll
                for (int kk = 0; kk < 4; ++kk) { const bf16x8 kf = *(const LAS bf16x8*)(KD + hg_row(16 + fr) + 32 * kk + 8 * fq); at1 = __builtin_amdgcn_mfma_f32_16x16x32_bf16(kf, qf[kk], at1, 0, 0, 0); } }
            const int cc = 16 * ct + fr;
#pragma unroll
            for (int r = 0; r < 4; ++r) { at0[r] = (4 * fq + r <= cc) ? at0[r] : 0.f; at1[r] = (ct == 1 && 16 + 4 * fq + r <= cc) ? at1[r] : 0.f; }
            u32x4 aw; aw.x = cvt_pk_bf16(at0[0], at0[1]); aw.y = cvt_pk_bf16(at0[2], at0[3]); aw.z = cvt_pk_bf16(at1[0], at1[1]); aw.w = cvt_pk_bf16(at1[2], at1[3]);
            const bf16x8 af = __builtin_bit_cast(bf16x8, aw);
            f32x4 o = (f32x4){0.f, 0.f, 0.f, 0.f};
#pragma unroll
            for (int kk = 0; kk < 4; ++kk) { const bf16x8 sf = *(const LAS bf16x8*)(ST + (16 * wid + fr) * 136 + 32 * kk + 8 * fq); o = __builtin_amdgcn_mfma_f32_16x16x32_bf16(qf[kk], sf, o, 0, 0, 0); }
            o = __builtin_amdgcn_mfma_f32_16x16x32_bf16(af, vBp, o, 0, 0, 0);
#pragma unroll
            for (int r = 0; r < 4; ++r) { const int ut = dir ? (SEQ - 1 - 12 - 32 * n - 16 * ct - r) : (32 * n + 16 * ct + r);
                (ufo + (size_t)ut * 256)[soff] = f2bf(o[r]); }
        }
#pragma unroll
        for (int i = 0; i < 8; ++i) { const f32x4 dec = *(const LAS f32x4*)(DEC + 16 * i + 4 * fq);
            const bf16x8 a = *(const LAS bf16x8*)(KET + (16 * i + fr) * 40 + 8 * fq);
            sacc[i] = __builtin_amdgcn_mfma_f32_16x16x32_bf16(a, vB, sacc[i] * dec, 0, 0, 0);
            u32x2 w; w.x = cvt_pk_bf16(sacc[i][0], sacc[i][1]); w.y = cvt_pk_bf16(sacc[i][2], sacc[i][3]);
            *(LAS u32x2*)(ST + (16 * wid + fr) * 136 + 16 * i + 4 * fq) = w; }
    }
}
__device__ __forceinline__ void hgrn_item(LAS unsigned char* lds, bf16_t* proj, const float* lbvec  , int item) {
    const int tid = opaque_tid(), lane = tid & 63, wid = __builtin_amdgcn_readfirstlane(tid >> 6);
    const int slot = (item & 255) >> 3, pair = (slot >> 1) + 16 * (item & 7) + 128 * (item >> 8);
    const int dir = slot & 1, h = pair & 15, bl = pair >> 4;
    const int fr = lane & 15, fq = lane >> 4, d = 16 * wid + fr;
    const int fcol = dir ? C_HFB : C_HFF;
    const float lb = lbvec[dir * DM + h * 128 + d];
    LAS bf16_t* ST = (LAS bf16_t*)(lds + HG_ST);
    for (int i = tid; i < 34816 / 4; i += 512) ((LAS unsigned*)ST)[i] = 0u;
    f32x4 sacc[8];
#pragma unroll
    for (int i = 0; i < 8; ++i) sacc[i] = (f32x4){0.f, 0.f, 0.f, 0.f};
    const size_t rowbase = (size_t)bl * SEQ;
    const bf16_t* uq = proj + pcol(C_HQ + h * 128) - (size_t)(h & 1) * 128 + rowbase * 256; bf16_t* uf = proj + pcol(fcol + h * 128) - (size_t)(h & 1) * 128 + rowbase * 256; const bf16_t* uv = proj + pcol(C_HI + h * 128) - (size_t)(h & 1) * 128 + rowbase * 256;
    const unsigned colw = (unsigned)((h & 1) * 128 + d);
    const unsigned voff = (unsigned)(dir ? (24 - 8 * fq) : 8 * fq) * 256u + colw;
    const unsigned soff = (unsigned)(dir ? (12 - 4 * fq) : 4 * fq) * 256u + colw;
    bf16_t rq[8], rf[8], rv[8], rq1[8], rf1[8], rv1[8];
#pragma unroll
    for (int i = 0; i < 8; ++i) { const int ut = dir ? (SEQ - 1 - 24 - i) : i; const size_t ro = (size_t)ut * 256; rq[i] = (uq + ro)[voff]; rf[i] = (uf + ro)[voff]; rv[i] = (uv + ro)[voff]; }
#pragma unroll
    for (int i = 0; i < 8; ++i) { const int ut = dir ? (SEQ - 1 - 24 - 32 - i) : (32 + i); const size_t ro = (size_t)ut * 256; rq1[i] = (uq + ro)[voff]; rf1[i] = (uf + ro)[voff]; rv1[i] = (uv + ro)[voff]; }
    BAR_LDS();
    for (int n = 0; n < SEQ / 32; n += 2) {
        hgrn_step(lds, uq, uf, uf, uv, voff, soff, n, dir, wid, fr, fq, d, lb, rq, rf, rv, sacc);
        hgrn_step(lds, uq, uf, uf, uv, voff, soff, n + 1, dir, wid, fr, fq, d, lb, rq1, rf1, rv1, sacc);
    }
    BAR_LDS();
}

constexpr int AT_QS = 0, AT_KS = 17408, AT_VT = AT_KS + 52224, AT_PS = AT_VT + 53248, AT_END = AT_PS + 4 * 5376;
static_assert(AT_END <= LDS_BYTES - 16, "attn lds");
struct AttnUnit { int g, hh, dl, seg, r, n, qcol; size_t rowbase; };
__device__ __forceinline__ AttnUnit attn_decode(int i) {
    const int u = (((i >> 8) * 8 + (i & 7)) << 5) + ((i & 255) >> 3);
    AttnUnit A; const int qb = u & 31; A.hh = (u >> 5) & 3; const int bl = (u >> 7) & 7; A.g = u >> 10;
    const int sh = 2 * A.g, nblk = 32 >> sh; A.dl = 1 << sh; A.seg = SEQ >> sh; A.r = qb / nblk; A.n = qb % nblk;
    A.qcol = C_QKV + A.g * 1536 + A.hh * 128; A.rowbase = (size_t)bl * SEQ; return A;
}
__device__ __forceinline__ void attn_load(const bf16_t* proj, const float* rope, const AttnUnit& A, int tid, u32x4 (&qr)[2], u32x4 (&kr)[6], u32x4 (&vr)[6], float (&cs)[8], float (&sn)[8]) {
#pragma unroll
    for (int it = 0; it < 2; ++it) { const int ci = tid + 512 * it, row = ci >> 4, ch = ci & 15; const int pos = (64 * A.n + row) * A.dl + A.r;
        qr[it] = *(const u32x4*)(proj + pcol(A.qcol) + (A.rowbase + pos) * 256 + 8 * ch); }
#pragma unroll
    for (int it = 0; it < 6; ++it) { const int ci = tid + 512 * it, ch = ci / 192, row = ci - 192 * ch; const int kj = 64 * A.n - 64 + row; const bool ok = (kj >= 0) && (kj < A.seg);
        const int pos = ok ? kj * A.dl + A.r : 0; const size_t ro = (A.rowbase + pos) * 256 + 8 * ch;
        kr[it] = *(const u32x4*)(proj + pcol(A.qcol + 512) + ro); vr[it] = *(const u32x4*)(proj + pcol(A.qcol + 1024) + ro); }
#pragma unroll
    for (int it = 0; it < 8; ++it) { const int idx = tid + 512 * it, row = idx >> 4, i = idx & 15; int pos;
        if (row < 64) pos = (64 * A.n + row) * A.dl + A.r; else { const int kj = 64 * A.n - 64 + (row - 64); pos = ((kj >= 0) && (kj < A.seg)) ? kj * A.dl + A.r : 0; }
        cs[it] = rope[pos * 32 + i]; sn[it] = rope[pos * 32 + 16 + i]; }
}
__device__ __forceinline__ void attn_phase(LAS unsigned char* lds, bf16_t* proj, float* lse, const float* rope, int u0, int ustride, int nunits) {
    const int tid = opaque_tid(), lane = tid & 63, wid = __builtin_amdgcn_readfirstlane(tid >> 6);
    LAS bf16_t* QS = (LAS bf16_t*)(lds + AT_QS); LAS bf16_t* KS = (LAS bf16_t*)(lds + AT_KS); LAS bf16_t* VT = (LAS bf16_t*)(lds + AT_VT);
    for (int i = tid; i < 128 * 16; i += 512) { const int rw = i >> 4, cc = i & 15; VT[rw * 208 + 192 + cc] = 0; }
    if (u0 >= nunits) { BAR_LDS(); return; }
    u32x4 qr[2], kr[6], vr[6]; float rcs[8], rsn[8];
    AttnUnit A = attn_decode(u0);
    attn_load(proj, rope, A, tid, qr, kr, vr, rcs, rsn);
    for (int u = u0; u < nunits; u += ustride) {
        const int n = A.n, dl = A.dl, r = A.r, seg = A.seg, hh = A.hh, g = A.g, qcol = A.qcol; const size_t rowbase = A.rowbase;
#pragma unroll
        for (int it = 0; it < 2; ++it) { const int ci = tid + 512 * it, row = ci >> 4, ch = ci & 15; *(LAS u32x4*)(QS + row * 136 + 8 * ch) = qr[it]; }
#pragma unroll
        for (int it = 0; it < 6; ++it) { const int ci = tid + 512 * it, ch = ci / 192, row = ci - 192 * ch; const int kj = 64 * n - 64 + row; const bool ok = (kj >= 0) && (kj < seg);
            u32x4 kv = kr[it], vv = vr[it];
            if (!ok) { kv = (u32x4){0u, 0u, 0u, 0u}; vv = (u32x4){0u, 0u, 0u, 0u}; }
            *(LAS u32x4*)(KS + row * 136 + 8 * ch) = kv;
            LAS bf16_t* vt = VT + (8 * ch) * 208 + row;
            vt[0 * 208] = (bf16_t)(vv.x & 0xffffu); vt[1 * 208] = (bf16_t)(vv.x >> 16); vt[2 * 208] = (bf16_t)(vv.y & 0xffffu); vt[3 * 208] = (bf16_t)(vv.y >> 16);
            vt[4 * 208] = (bf16_t)(vv.z & 0xffffu); vt[5 * 208] = (bf16_t)(vv.z >> 16); vt[6 * 208] = (bf16_t)(vv.w & 0xffffu); vt[7 * 208] = (bf16_t)(vv.w >> 16); }
        float cs[8], sn[8];
#pragma unroll
        for (int it = 0; it < 8; ++it) { cs[it] = rcs[it]; sn[it] = rsn[it]; }
        BAR_LDS();
        if (u + ustride < nunits) { A = attn_decode(u + ustride); attn_load(proj, rope, A, tid, qr, kr, vr, rcs, rsn); }
#pragma unroll
        for (int it = 0; it < 8; ++it) { const int idx = tid + 512 * it, row = idx >> 4, i = idx & 15;
            int pos; LAS bf16_t* p; bool ok = true;
            if (row < 64) { pos = (64 * n + row) * dl + r; p = QS + row * 136; }
            else { const int kj = 64 * n - 64 + (row - 64); ok = (kj >= 0) && (kj < seg); pos = ok ? kj * dl + r : 0; p = KS + (row - 64) * 136; }
            const float x1 = bf2f(p[i]), x2 = bf2f(p[16 + i]);
            if (ok) { p[i] = f2bf(x1 * cs[it] - x2 * sn[it]); p[16 + i] = f2bf(x2 * cs[it] + x1 * sn[it]); } }
        BAR_LDS();
        if (wid < 4) {
            const int w = wid, fr = lane & 15, fq = lane >> 4;
            LAS bf16_t* PS = (LAS bf16_t*)(lds + AT_PS + w * 5376);
            bf16x8 aq[4];
#pragma unroll
            for (int kk = 0; kk < 4; ++kk) aq[kk] = *(const LAS bf16x8*)(QS + (16 * w + fr) * 136 + 32 * kk + 8 * fq);
            f32x4 sc[9];
#pragma unroll
            for (int t = 0; t < 9; ++t) { sc[t] = (f32x4){0.f, 0.f, 0.f, 0.f};
#pragma unroll
                for (int kk = 0; kk < 4; ++kk) { const bf16x8 b = *(const LAS bf16x8*)(KS + (16 * (w + t) + fr) * 136 + 32 * kk + 8 * fq);
                    sc[t] = __builtin_amdgcn_mfma_f32_16x16x32_bf16(aq[kk], b, sc[t], 0, 0, 0); } }
            float mx[4] = {-3.0e38f, -3.0e38f, -3.0e38f, -3.0e38f};
#pragma unroll
            for (int t = 0; t < 9; ++t)
#pragma unroll
                for (int rr = 0; rr < 4; ++rr) { const int ql = 16 * w + 4 * fq + rr, jj = 16 * (w + t) + fr; const int kj = 64 * n - 64 + jj; const int dd = ql + 64 - jj;
                    const bool ok = (dd <= 64) && (dd >= -64) && (kj >= 0) && (kj < seg);
                    const float val = ok ? sc[t][rr] * 0.08838834764831845f : -1.0e30f; sc[t][rr] = val; mx[rr] = fmaxf(mx[rr], val); }
#pragma unroll
            for (int rr = 0; rr < 4; ++rr) {
#pragma unroll
                for (int o = 1; o < 16; o <<= 1) mx[rr] = fmaxf(mx[rr], __shfl_xor(mx[rr], o)); }
            float sm[4] = {0.f, 0.f, 0.f, 0.f};
#pragma unroll
            for (int t = 0; t < 9; ++t)
#pragma unroll
                for (int rr = 0; rr < 4; ++rr) { const float p = __expf(sc[t][rr] - mx[rr]); sm[rr] += p; PS[(4 * fq + rr) * 168 + 16 * t + fr] = f2bf(p); }
#pragma unroll
            for (int rr = 0; rr < 4; ++rr) { PS[(4 * fq + rr) * 168 + 144 + fr] = 0;
#pragma unroll
                for (int o = 1; o < 16; o <<= 1) sm[rr] += __shfl_xor(sm[rr], o); }
            LDS_WAIT();
            f32x4 oacc[8];
#pragma unroll
            for (int nt = 0; nt < 8; ++nt) oacc[nt] = (f32x4){0.f, 0.f, 0.f, 0.f};
#pragma unroll
            for (int kk = 0; kk < 5; ++kk) { const bf16x8 a = *(const LAS bf16x8*)(PS + fr * 168 + 32 * kk + 8 * fq);
#pragma unroll
                for (int nt = 0; nt < 8; ++nt) { const bf16x8 b = *(const LAS bf16x8*)(VT + (16 * nt + fr) * 208 + 16 * w + 32 * kk + 8 * fq);
                    oacc[nt] = __builtin_amdgcn_mfma_f32_16x16x32_bf16(a, b, oacc[nt], 0, 0, 0); } }
#pragma unroll
            for (int rr = 0; rr < 4; ++rr) { const int ql = 16 * w + 4 * fq + rr; const int pos = (64 * n + ql) * dl + r; const float inv = 1.0f / sm[rr];
                bf16_t* orow = proj + pcol(qcol) + (rowbase + pos) * 256;
#pragma unroll
                for (int nt = 0; nt < 8; ++nt) orow[16 * nt + fr] = f2bf(oacc[nt][rr] * inv);
                if (fr == 0) lse[((size_t)g * MH + rowbase + pos) * 4 + hh] = mx[rr] + __logf(sm[rr]); }
        }
        BAR_LDS();
    }
}

__device__ __forceinline__ void mixer_finalize(bf16_t* proj, const float* lse, const float* normg, bf16_t* ohg, bf16_t* attnc) {
    const int tid = opaque_tid(), lane = tid & 63, gw = blockIdx.x * 8 + (tid >> 6), ngw = gridDim.x * 8;
    for (int m = gw; m < MH; m += ngw) {
        const bf16_t* row = proj + (size_t)m * 256;
        float o[32]; float ss = 0.f;
#pragma unroll
        for (int j = 0; j < 4; ++j) { float a[8], b[8]; unpack8(*(const u32x4*)(row + pcol(C_HFF + 32 * lane + 8 * j)), a); unpack8(*(const u32x4*)(row + pcol(C_HFB + 32 * lane + 8 * j)), b);
#pragma unroll
            for (int k = 0; k < 8; ++k) { const float x = a[k] + b[k]; o[8 * j + k] = x; ss += x * x; } }
        ss += __shfl_xor(ss, 1); ss += __shfl_xor(ss, 2);
        const float rs = 1.0f / sqrtf(ss * (1.f / 128.f) + LN_EPS);
#pragma unroll
        for (int j = 0; j < 4; ++j) { float og[8], res[8]; unpack8(*(const u32x4*)(row + pcol(C_HOG + 32 * lane + 8 * j)), og);
            const f32x4 g0 = *(const f32x4*)(normg + 32 * lane + 8 * j), g1 = *(const f32x4*)(normg + 32 * lane + 8 * j + 4);
#pragma unroll
            for (int k = 0; k < 8; ++k) res[k] = o[8 * j + k] * rs * (k < 4 ? g0[k] : g1[k - 4]) * siluf_(og[k]);
            *(u32x4*)(ohg + (size_t)m * DM + 32 * lane + 8 * j) = pack8(res); }
        const int hh = lane >> 4, d = 8 * (lane & 15);
        const float l0 = lse[((size_t)0 * MH + m) * 4 + hh], l1 = lse[((size_t)1 * MH + m) * 4 + hh], l2 = lse[((size_t)2 * MH + m) * 4 + hh];
        const float mxl = fmaxf(l0, fmaxf(l1, l2)); float w0 = __expf(l0 - mxl), w1 = __expf(l1 - mxl), w2 = __expf(l2 - mxl); const float iw = 1.0f / (w0 + w1 + w2); w0 *= iw; w1 *= iw; w2 *= iw;
        float a0[8], a1[8], a2[8], res[8];
        unpack8(*(const u32x4*)(row + pcol(C_QKV + 0 * 1536 + hh * 128 + d)), a0); unpack8(*(const u32x4*)(row + pcol(C_QKV + 1 * 1536 + hh * 128 + d)), a1); unpack8(*(const u32x4*)(row + pcol(C_QKV + 2 * 1536 + hh * 128 + d)), a2);
#pragma unroll
        for (int k = 0; k < 8; ++k) res[k] = w0 * a0[k] + w1 * a1[k] + w2 * a2[k];
        *(u32x4*)(attnc + (size_t)m * 512 + hh * 128 + d) = pack8(res);
    }
}

#ifndef PROBE_MASK
#define PROBE_MASK 0
#endif
#ifndef PROBE_MODE
#define PROBE_MODE 0
#endif
#define PB_GEMM_FFN 1
#define PB_GEMM_MIX 2
#define PB_HGRN 4
#define PB_ATTN 8
#define PB_FIN 16
#define PB_LN 32
#define PB_PRO 64
#define PB_BAR 128
#define TIC() do { if (PROBE_MASK) { __builtin_amdgcn_s_barrier(); pb_t0 = __builtin_amdgcn_s_memrealtime(); } } while (0)
#define TOC(bit) do { if (PROBE_MASK & (bit)) { __builtin_amdgcn_s_barrier(); pb_acc += __builtin_amdgcn_s_memrealtime() - pb_t0; } } while (0)
#define XB_TMO      128
#define XB_XCNT(j)  (256  + 64 * (j))
#define XB_XSUB(j)  (1280 + 64 * (j))
#define XB_XGEN(j)  (2304 + 64 * (j))
#define XB_TOP      3328
#define XB_TOPGEN   3392
#define XCD_BAR_WORDS 3456
#define XB_SPIN_CAP (1u << 18)
__device__ __forceinline__ unsigned xb_ld(unsigned* p)              { return __hip_atomic_load(p, __ATOMIC_RELAXED, __HIP_MEMORY_SCOPE_AGENT); }
__device__ __forceinline__ unsigned xb_add(unsigned* p, unsigned v) { return __hip_atomic_fetch_add(p, v, __ATOMIC_RELAXED, __HIP_MEMORY_SCOPE_AGENT); }
__device__ __forceinline__ unsigned xb_xcc_id() { return (unsigned)__builtin_amdgcn_s_getreg((3 << 11) | 20) & 0xFu; }
#define XB_SPIN(cond, bar) do { unsigned _sp = 0; while (cond) { __builtin_amdgcn_s_sleep(1); \
    if ((++_sp & 255u) == 0u) { if (xb_ld(&(bar)[XB_TMO])) break; if (_sp > XB_SPIN_CAP) { atomicAdd(&(bar)[XB_TMO], 1u); break; } } } } while (0)
struct XcdBarrier { unsigned* bar; unsigned x; volatile LAS unsigned* st; };
__device__ __forceinline__ XcdBarrier xcd_barrier_post(unsigned* bar, volatile LAS unsigned* st) {
    XcdBarrier b; b.bar = bar; b.x = xb_xcc_id(); b.st = st;
    if (threadIdx.x == 0) (void)xb_add(&bar[XB_XCNT(b.x)], 1u);
    return b;
}
__device__ __forceinline__ void xcd_barrier_complete(unsigned* bar, unsigned x, unsigned& nloc, unsigned& nx) {
    const unsigned G = gridDim.x * gridDim.y * gridDim.z;
    unsigned sum, cnt, mine, sp = 0u;
    for (;;) {
        sum = 0u; cnt = 0u; mine = 0u;
#pragma unroll
        for (unsigned j = 0; j < 16; ++j) { const unsigned c = xb_ld(&bar[XB_XCNT(j)]); sum += c; cnt += (c > 0u) ? 1u : 0u; mine = (j == x) ? c : mine; }
        if (sum == G) break;
        __builtin_amdgcn_s_sleep(1);
        if ((++sp & 255u) == 0u) { if (xb_ld(&bar[XB_TMO])) break; if (sp > XB_SPIN_CAP) { atomicAdd(&bar[XB_TMO], 1u); break; } }
    }
    nloc = mine > 0u ? mine : 1u; nx = cnt > 0u ? cnt : 1u;
}
__device__ __forceinline__ void xcd_barrier(const XcdBarrier& b) {
    asm volatile("s_waitcnt vmcnt(0) lgkmcnt(0)" ::: "memory");
    __syncthreads();
    if (threadIdx.x == 0) {
        unsigned* bar = b.bar;
        __builtin_amdgcn_s_waitcnt(0);
        unsigned nloc = b.st[0], nx = b.st[1];
        if (nloc == 0u) { xcd_barrier_complete(bar, b.x, nloc, nx); b.st[0] = nloc; b.st[1] = nx; }
        const unsigned old = xb_add(&bar[XB_XSUB(b.x)], 1u);
        const unsigned gen = old / nloc;
        if (old + 1u == (gen + 1u) * nloc) {
            __builtin_amdgcn_fence(__ATOMIC_RELEASE, "agent");
            asm volatile("s_waitcnt vmcnt(0)" ::: "memory");
            const unsigned og = xb_add(&bar[XB_TOP], 1u);
            const unsigned tg = og / nx;
            if (og + 1u == (tg + 1u) * nx) xb_add(&bar[XB_TOPGEN], 1u);
            else XB_SPIN(xb_ld(&bar[XB_TOPGEN]) == tg, bar);
            __builtin_amdgcn_fence(__ATOMIC_ACQUIRE, "agent");
            xb_add(&bar[XB_XGEN(b.x)], 1u);
            asm volatile("s_waitcnt vmcnt(0)" ::: "memory");
        } else {
            XB_SPIN(xb_ld(&bar[XB_XGEN(b.x)]) == gen, bar);
            __builtin_amdgcn_fence(__ATOMIC_ACQUIRE, "agent");
            asm volatile("s_waitcnt vmcnt(0)" ::: "memory");
        }
    }
    __syncthreads();
    asm volatile("" ::: "memory");
}
__device__ __forceinline__ void grid_barrier_ctr(unsigned* cnt, unsigned& target, unsigned nblk) {
    asm volatile("s_waitcnt vmcnt(0) lgkmcnt(0)" ::: "memory");
    __builtin_amdgcn_s_barrier();
    target += nblk;
    if (threadIdx.x == 0) {
        __builtin_amdgcn_fence(__ATOMIC_RELEASE, "agent");
        asm volatile("s_waitcnt vmcnt(0)" ::: "memory");
        __hip_atomic_fetch_add(cnt, 1u, __ATOMIC_RELAXED, __HIP_MEMORY_SCOPE_AGENT);
        while (__hip_atomic_load(cnt, __ATOMIC_RELAXED, __HIP_MEMORY_SCOPE_AGENT) < target) __builtin_amdgcn_s_sleep(1);
        __builtin_amdgcn_fence(__ATOMIC_ACQUIRE, "agent");
        asm volatile("s_waitcnt vmcnt(0)" ::: "memory");
    }
    __builtin_amdgcn_s_barrier();
    asm volatile("" ::: "memory");
}
__device__ __forceinline__ void grid_barrier(cg::grid_group& grid) {
    asm volatile("s_waitcnt vmcnt(0) lgkmcnt(0)" ::: "memory");
    grid.sync();
    asm volatile("" ::: "memory");
}
struct Params { const float* in[18]; float* out; unsigned char* ws; };

__global__ void __launch_bounds__(512, 2) fwd_kernel(Params P) {
    extern __shared__ __attribute__((aligned(16))) unsigned char lds_raw[];
    LAS unsigned char* lds = (LAS unsigned char*)lds_raw;
    cg::grid_group grid = cg::this_grid();
    const int G = gridDim.x, bx = blockIdx.x;
    unsigned long long pb_t0 = 0, pb_acc = 0;
    unsigned* BARCNT = (unsigned*)(P.ws + OFF_BAR); unsigned bar_target = 0;
    volatile LAS unsigned* xb_st = (volatile LAS unsigned*)(lds + LDS_BYTES - 16);
    if (threadIdx.x == 0) { xb_st[0] = 0u; xb_st[1] = 0u; }
    __syncthreads();
    const XcdBarrier xbar = xcd_barrier_post(BARCNT, xb_st);
    unsigned char* ws = P.ws;
    bf16_t* W1IN = (bf16_t*)(ws + OFF_W1IN); bf16_t* W1OUT = (bf16_t*)(ws + OFF_W1OUT); bf16_t* WMIX = (bf16_t*)(ws + OFF_WMIX);
    bf16_t* WA = (bf16_t*)(ws + OFF_WA); bf16_t* WB = (bf16_t*)(ws + OFF_WB); bf16_t* WO = (bf16_t*)(ws + OFF_WO);
    bf16_t* W2IN = (bf16_t*)(ws + OFF_W2IN); bf16_t* W2OUT = (bf16_t*)(ws + OFF_W2OUT);
    bf16_t* XB = (bf16_t*)(ws + OFF_XB); bf16_t* PROJ = (bf16_t*)(ws + OFF_PROJ); bf16_t* HID = PROJ;
    float* LSE = (float*)(ws + OFF_LSE); float* ROPE = (float*)(ws + OFF_ROPE); float* LB = (float*)(ws + OFF_LB);
    float* OUT = P.out;
    bf16_t* OHG = (bf16_t*)(ws + OFF_OHG); bf16_t* ATTNC = (bf16_t*)(ws + OFF_ATTNC);
    bf16_t* ZF = (bf16_t*)(ws + OFF_PROJ + (size_t)MTOK * DFF * 2);
    bf16_t* ZM = OHG;

    TIC();
    {
        const int tid = opaque_tid(), lane = tid & 63, wave = __builtin_amdgcn_readfirstlane(tid >> 6), gw = bx * 8 + wave, ngw = G * 8;
        LAS float* scr = (LAS float*)(lds + wave * 8448);
        constexpr int I_IN = (DM / 64) * (2 * DFF / 32), I_OUT = (DFF / 64) * (DM / 32), I_MIX = (DM / 64) * (INC / 32), I_A = (DM / 64) * (DM / 32), I_B = (512 / 64) * (DM / 32);
        constexpr int NITEMS = 2 * (I_IN + I_OUT) + I_MIX + 2 * I_A + I_B;
        for (int it = gw; it < NITEMS; it += ngw) {
            int r = it;
            if (r < I_IN) { transpose_item(P.in[1], DM, 2 * DFF, W1IN, scr, r, lane, 1); continue; } r -= I_IN;
            if (r < I_OUT) { transpose_item(P.in[2], DFF, DM, W1OUT, scr, r, lane, 0); continue; } r -= I_OUT;
            if (r < I_MIX) { transpose_item(P.in[5], DM, INC, WMIX, scr, r, lane, 0); continue; } r -= I_MIX;
            if (r < I_A) { transpose_item(P.in[9], DM, DM, WA, scr, r, lane, 0); continue; } r -= I_A;
            if (r < I_B) { transpose_item(P.in[10], 512, DM, WB, scr, r, lane, 0); continue; } r -= I_B;
            if (r < I_A) { transpose_item(P.in[11], DM, DM, WO, scr, r, lane, 0); continue; } r -= I_A;
            if (r < I_IN) { transpose_item(P.in[14], DM, 2 * DFF, W2IN, scr, r, lane, 1); continue; } r -= I_IN;
            transpose_item(P.in[15], DFF, DM, W2OUT, scr, r, lane, 0);
        }
        const size_t nth = (size_t)G * 512, gt = (size_t)bx * 512 + tid;
        const f32x4* x4 = (const f32x4*)P.in[0];
        for (size_t i = gt; i < (size_t)MTOK * DM / 8; i += nth) { const f32x4 a = x4[2 * i], b = x4[2 * i + 1];
            u32x4 w; w.x = cvt_pk_bf16(a.x, a.y); w.y = cvt_pk_bf16(a.z, a.w); w.z = cvt_pk_bf16(b.x, b.y); w.w = cvt_pk_bf16(b.z, b.w); ((u32x4*)XB)[i] = w; }
        for (size_t i = gt; i < (size_t)SEQ * 16; i += nth) { const int pos = (int)(i >> 4), k = (int)(i & 15);
            const float invf = exp2f(-(float)k * (18.931568569324174f / 16.0f));
            const float ang = (float)pos * invf;
            const float kr = rintf(ang * 0.15915494309189535f);
            float rr = fmaf(-kr, 6.2831854820251465f, ang); rr = fmaf(-kr, -1.7484555e-7f, rr);
            ROPE[pos * 32 + k] = cosf(rr); ROPE[pos * 32 + 16 + k] = sinf(rr); }
        for (size_t i = gt; i < (size_t)2 * DM; i += nth) { const int dirr = (int)(i / DM), ch = (int)(i % DM); const float* tb = P.in[6 + dirr];
            LB[i] = 1.0f / (1.0f + expf(tb[DM + ch] - tb[ch])); }
    }
    TOC(PB_PRO);
    if (P.ws == nullptr) grid_barrier(grid);
    { TIC(); xcd_barrier(xbar); TOC(PB_BAR); }

#pragma unroll 1
    for (int f = 0; f < 2; ++f) {
        if (f == 1) {
#pragma unroll 1
            for (int hb = 0; hb < NHALF; ++hb) {
#ifdef SKIP_MIXER
                break;
#endif
                const size_t tok0 = (size_t)hb * MH;
                TIC();
                { pg8::Gemm g{XB + tok0 * DM, WMIX, MH, INC, DM, DM}; pg8::StaticOrder S; S.init(MH, INC, G, bx); pg8::EpiBf16 E{PROJ, PTILE};
                  pg8::gemm_phase<pg8::EpiBf16>(lds, g, S, E); }
                TOC(PB_GEMM_MIX);
                { TIC(); xcd_barrier(xbar); TOC(PB_BAR); }
                TIC();
#ifndef SKIP_HGRN
                for (int it = bx; it < BH * 16 * 2; it += G) hgrn_item(lds, PROJ, LB, it);
#endif
                TOC(PB_HGRN);
                TIC();
                attn_phase(lds, PROJ, LSE, ROPE, bx, G, 3 * BH * 4 * 32);
                TOC(PB_ATTN);
                { TIC(); xcd_barrier(xbar); TOC(PB_BAR); }
                TIC();
#ifndef SKIP_FIN
                mixer_finalize(PROJ, LSE, P.in[8], OHG, ATTNC);
#endif
                TOC(PB_FIN);
                { TIC(); xcd_barrier(xbar); TOC(PB_BAR); }
                TIC();
                bf16_t* MIXB = PROJ;
                { pg8::Gemm g{OHG, WA, MH, DM, DM, DM}; pg8::StaticOrder S; S.init(MH, DM, G, bx, 4); pg8::EpiGate<0> E{PROJ + pcol(C_GA), PTILE, MIXB, DM};
                  pg8::gemm_phase<pg8::EpiGate<0>>(lds, g, S, E); }
                { pg8::Gemm g{ATTNC, WB, MH, DM, 512, 512}; pg8::StaticOrder S; S.init(MH, DM, G, bx, 4); pg8::EpiGate<1> E{PROJ + pcol(C_GB), PTILE, MIXB, DM};
                  pg8::gemm_phase<pg8::EpiGate<1>>(lds, g, S, E); }
                TOC(PB_GEMM_MIX);
                { TIC(); xcd_barrier(xbar); TOC(PB_BAR); }
                TIC();
                { pg8::Gemm g{MIXB, WO, MH, DM, DM, DM}; pg8::StaticOrder S; S.init(MH, DM, G, bx, 4); pg8::EpiScaleBf16 E{ZM, DM, 1.0f};
                  pg8::gemm_phase<pg8::EpiScaleBf16>(lds, g, S, E); }
                TOC(PB_GEMM_MIX);
                { TIC(); xcd_barrier(xbar); TOC(PB_BAR); }
                TIC();
                ln_rows<true>(XB, ZM, nullptr, XB, P.in[12], P.in[13], (int)tok0, MH);
                TOC(PB_LN);
                if (hb == NHALF - 1) { TIC(); xcd_barrier(xbar); TOC(PB_BAR); }
            }
        }
        TIC();
        { pg8::Gemm g{XB, f ? W2IN : W1IN, MTOK, 2 * DFF, DM, DM}; pg8::StaticOrder S; S.init(MTOK, 2 * DFF, G, bx); pg8::EpiSwiglu E{HID, DFF};
          pg8::gemm_phase<pg8::EpiSwiglu>(lds, g, S, E); }
        TOC(PB_GEMM_FFN);
        { TIC(); xcd_barrier(xbar); TOC(PB_BAR); }
        TIC();
        { pg8::Gemm g{HID, f ? W2OUT : W1OUT, MTOK, DM, DFF, DFF}; pg8::StaticOrder S; S.init(MTOK, DM, G, bx, 4); pg8::EpiScaleBf16 E{ZF, DM, 0.5f};
          pg8::gemm_phase<pg8::EpiScaleBf16>(lds, g, S, E); }
        TOC(PB_GEMM_FFN);
        { TIC(); xcd_barrier(xbar); TOC(PB_BAR); }
        TIC();
        if (f == 0) ln_rows<false>(P.in[0], ZF, nullptr, XB, P.in[3], P.in[4], 0, MTOK);
        else ln_rows<true>(XB, ZF, OUT, nullptr, P.in[16], P.in[17], 0, MTOK);
        TOC(PB_LN);
        if (f == 0) { TIC(); xcd_barrier(xbar); TOC(PB_BAR); }
    }
    if (PROBE_MASK) {
        unsigned long long* pw = (unsigned long long*)(P.ws + OFF_BAR + 64);
        if (PROBE_MODE != 0) {
            if (threadIdx.x == 0) atomicMax(pw, PROBE_MODE == 1 ? pb_acc : ((1ull << 40) - pb_acc));
            grid_barrier_ctr(BARCNT, bar_target, (unsigned)G);
            if (threadIdx.x == 0) { const unsigned long long v = __hip_atomic_load(pw, __ATOMIC_RELAXED, __HIP_MEMORY_SCOPE_AGENT); pb_acc = PROBE_MODE == 1 ? v : ((1ull << 40) - v); }
        }
        if (bx == 0 && threadIdx.x == 0) { const unsigned long long t1 = __builtin_amdgcn_s_memrealtime(); while (__builtin_amdgcn_s_memrealtime() - t1 < pb_acc) __builtin_amdgcn_s_sleep(8); }
    }
}

extern "C" void kernel_launch(void* const* d_in, const int* in_sizes, int n_in, void* d_out, int out_size, void* d_ws, size_t ws_size, hipStream_t stream) {
    static int grid_blocks = 0;
    if (grid_blocks == 0) {
        if (n_in != 18 || ws_size < WS_END2) { fprintf(stderr, "kernel_launch: need 18 inputs and >= %zu bytes of workspace; got %d, %zu\n", (size_t)WS_END2, n_in, ws_size); grid_blocks = -1; return; }
        int dev = 0, cus = 0, per_cu = 0;
        hipGetDevice(&dev);
        hipDeviceGetAttribute(&cus, hipDeviceAttributeMultiprocessorCount, dev);
        if (hipFuncSetAttribute((const void*)fwd_kernel, hipFuncAttributeMaxDynamicSharedMemorySize, LDS_BYTES) != hipSuccess) fprintf(stderr, "kernel_launch: hipFuncSetAttribute failed\n");
        hipOccupancyMaxActiveBlocksPerMultiprocessor(&per_cu, (const void*)fwd_kernel, 512, LDS_BYTES);
        if (per_cu < 1) { fprintf(stderr, "kernel_launch: occupancy query says %d blocks per CU\n", per_cu); per_cu = 1; }
        (void)hipGetLastError();
        grid_blocks = cus * per_cu;
    }
    if (grid_blocks < 0) return;
    (void)hipMemsetAsync((char*)d_ws + OFF_BAR, 0, BAR_BYTES, stream);
    Params p{};
    for (int i = 0; i < 18; ++i) p.in[i] = (const float*)d_in[i];
    p.out = (float*)d_out; p.ws = (unsigned char*)d_ws;
    void* args[] = {&p};
    hipError_t e = hipLaunchCooperativeKernel((const void*)fwd_kernel, dim3(grid_blocks), dim3(512), args, LDS_BYTES, stream);
    if (e != hipSuccess) fprintf(stderr, "cooperative launch failed: %s (grid %d)\n", hipGetErrorString(e), grid_blocks);
}
```
